# Optimizing an MI355X kernel written in HIP

```python
import math
import jax, jax.numpy as jnp
from jax import lax
import numpy as np

D_MODEL = 1024
BATCH = 16
SEQ = 2048
DEPTH = 2

EPS = 1e-6
HEAD_DIM = 64
Q_BLOCK = 128
LRU_WIDTH = 512
LRU_BLOCKS = 8
LRU_BLOCK = LRU_WIDTH // LRU_BLOCKS
CONV_WIDTH = 4
LRU_C = 8.0
NSA_HEADS = 8
NSA_KV_GROUPS = 2
NSA_HPG = NSA_HEADS // NSA_KV_GROUPS
CMP_LEN = 32
CMP_STRIDE = 16
CMP_HIDDEN = 128
SLC_LEN = 64
SLC_TOPN = 8
WIN = 512
FORCE_SCORE = 1e4
DSA_HEADS = 16
DSA_KV_HEADS = 2
DSA_HPG = DSA_HEADS // DSA_KV_HEADS
IDX_HEADS = 8
IDX_DIM = 64
IDX_TOPK_MAX = 256
D_FF = -(-8 * D_MODEL // (3 * 256)) * 256
NSA_Q = NSA_HEADS * HEAD_DIM
NSA_KV = NSA_KV_GROUPS * HEAD_DIM
IN0_SIZES = (LRU_WIDTH, LRU_WIDTH, NSA_Q, NSA_KV, NSA_KV, NSA_KV, NSA_KV, NSA_KV, NSA_KV, NSA_HEADS * 3)
IN0 = sum(IN0_SIZES)
MIX0 = LRU_WIDTH + NSA_Q
IN1_SIZES = (DSA_HEADS * HEAD_DIM, DSA_KV_HEADS * HEAD_DIM, DSA_KV_HEADS * HEAD_DIM, IDX_HEADS * IDX_DIM, IDX_DIM, IDX_HEADS)
IN1 = sum(IN1_SIZES)
MIX1 = DSA_HEADS * HEAD_DIM

kernel_name = "hybrid_rglru_nsa_dsa_adaln"


def _split(t, sizes):
    return jnp.split(t, np.cumsum(sizes)[:-1].tolist(), axis=-1)


def rmsnorm(x, g):
    xf = x.astype(jnp.float32)
    y = xf * lax.rsqrt(jnp.mean(xf * xf, axis=-1, keepdims=True) + EPS)
    return (y * g.astype(jnp.float32)).astype(x.dtype)


def modulate(x, g, shift, scale):
    return rmsnorm(x, g) * (1.0 + scale[:, None, :]) + shift[:, None, :]


def masked_softmax(s, mask):
    s = jnp.where(mask, s.astype(jnp.float32), -jnp.inf)
    m = jnp.max(s, axis=-1, keepdims=True)
    m = jnp.where(jnp.isfinite(m), m, 0.0)
    p = jnp.exp(s - m)
    return p / jnp.maximum(jnp.sum(p, axis=-1, keepdims=True), 1e-30)


def swiglu(h, wg, wu, wd):
    return (jax.nn.silu(h @ wg) * (h @ wu)) @ wd


def adaln(c, w_mod, b_mod):
    mod = jax.nn.silu(c) @ w_mod + b_mod
    return jnp.split(mod, 6, axis=-1)


def causal_conv(x, w, b):
    S = x.shape[1]
    xp = jnp.pad(x, ((0, 0), (CONV_WIDTH - 1, 0), (0, 0)))
    out = xp[:, 0:S] * w[0]
    for k in range(1, CONV_WIDTH):
        out = out + xp[:, k:k + S] * w[k]
    return out + b


def rg_lru(x, wa, ba, wx, bx, lam):
    B, S, _ = x.shape
    xf = x.astype(jnp.float32)
    xb = xf.reshape(B, S, LRU_BLOCKS, LRU_BLOCK)
    r = jax.nn.sigmoid(jnp.einsum('bshi,hij->bshj', xb, wa).reshape(B, S, LRU_WIDTH) + ba)
    i = jax.nn.sigmoid(jnp.einsum('bshi,hij->bshj', xb, wx).reshape(B, S, LRU_WIDTH) + bx)
    log_a = -LRU_C * r * jax.nn.softplus(-lam.astype(jnp.float32))
    a = jnp.exp(log_a)
    mult = jnp.sqrt(-jnp.expm1(2.0 * log_a))
    mult = jnp.where((jnp.arange(S) == 0)[None, :, None], 1.0, mult)
    u = mult * (i * xf)

    def combine(e1, e2):
        a1, b1 = e1
        a2, b2 = e2
        return a1 * a2, a2 * b1 + b2

    _, h = lax.associative_scan(combine, (a, u), axis=1)
    return h.astype(x.dtype)


def compress_blocks(kv, pe, w1, w2):
    B, S, G, D = kv.shape
    nc = (S - CMP_LEN) // CMP_STRIDE + 1
    idx = jnp.arange(nc)[:, None] * CMP_STRIDE + jnp.arange(CMP_LEN)[None, :]
    blk = kv[:, idx] + pe[:, None, :]
    flat = blk.transpose(0, 1, 3, 2, 4).reshape(B, nc, G, CMP_LEN * D)
    return jax.nn.gelu(flat @ w1) @ w2


def nsa_mixer(q, k_cmp, v_cmp, k_slc, v_slc, k_win, v_win, gates, pe_k, w1_k, w2_k, pe_v, w1_v, w2_v):
    B, S = q.shape[:2]
    G, R, D = NSA_KV_GROUPS, NSA_HPG, HEAD_DIM
    scale = D ** -0.5
    nc = (S - CMP_LEN) // CMP_STRIDE + 1
    nsel = S // SLC_LEN
    n_top = min(SLC_TOPN, nsel)
    rs = lambda t: t.reshape(B, S, G, D)
    kc = compress_blocks(rs(k_cmp), pe_k, w1_k, w2_k)
    vc = compress_blocks(rs(v_cmp), pe_v, w1_v, w2_v)
    ks = rs(k_slc).reshape(B, nsel, SLC_LEN, G, D).transpose(0, 3, 1, 2, 4)
    vs = rs(v_slc).reshape(B, nsel, SLC_LEN, G, D).transpose(0, 3, 1, 2, 4)
    pad = ((0, 0), (WIN, 0), (0, 0), (0, 0))
    kw_pad = jnp.pad(rs(k_win), pad)
    vw_pad = jnp.pad(rs(v_win), pad)
    c_start = jnp.arange(nc) * CMP_STRIDE
    c_end = c_start + CMP_LEN - 1
    j_start = jnp.arange(nsel) * SLC_LEN
    overlap = ((c_start[:, None] < j_start[None, :] + SLC_LEN)
               & (c_start[:, None] + CMP_LEN > j_start[None, :])).astype(jnp.float32)
    jj = jnp.arange(nsel)
    b_i = jnp.arange(B)[:, None, None, None]
    g_i = jnp.arange(G)[None, :, None, None]

    def block(ib):
        t0 = ib * Q_BLOCK
        tq = t0 + jnp.arange(Q_BLOCK)
        qc = lax.dynamic_slice_in_dim(q, t0, Q_BLOCK, axis=1).reshape(B, Q_BLOCK, G, R, D)
        gc = lax.dynamic_slice_in_dim(gates, t0, Q_BLOCK, axis=1).reshape(B, Q_BLOCK, G, R, 3)
        s = jnp.einsum('bqgrd,bcgd->bgrqc', qc, kc) * scale
        p_cmp = masked_softmax(s, c_end[None, :] <= tq[:, None])
        o_cmp = jnp.einsum('bgrqc,bcgd->bqgrd', p_cmp, vc)
        imp = jnp.einsum('bgrqc,cj->bgqj', p_cmp, overlap)
        cur = tq // SLC_LEN
        forced = (jj[None, :] == 0) | (jj[None, :] == cur[:, None]) | (jj[None, :] == cur[:, None] - 1)
        imp = jnp.where(forced, FORCE_SCORE, imp)
        imp = jnp.where(jj[None, :] <= cur[:, None], imp, -jnp.inf)
        _, sel = lax.top_k(imp, n_top)
        kg = ks[b_i, g_i, sel].reshape(B, G, Q_BLOCK, n_top * SLC_LEN, D)
        vg = vs[b_i, g_i, sel].reshape(B, G, Q_BLOCK, n_top * SLC_LEN, D)
        kpos = sel[..., None] * SLC_LEN + jnp.arange(SLC_LEN)
        smask = (kpos <= tq[:, None, None]).reshape(B, G, 1, Q_BLOCK, n_top * SLC_LEN)
        s = jnp.einsum('bqgrd,bgqkd->bgrqk', qc, kg) * scale
        o_slc = jnp.einsum('bgrqk,bgqkd->bqgrd', masked_softmax(s, smask), vg)
        kw = lax.dynamic_slice_in_dim(kw_pad, t0, WIN + Q_BLOCK, axis=1)
        vw = lax.dynamic_slice_in_dim(vw_pad, t0, WIN + Q_BLOCK, axis=1)
        kpw = t0 - WIN + jnp.arange(WIN + Q_BLOCK)
        wmask = (kpw[None, :] >= 0) & (kpw[None, :] <= tq[:, None]) & (kpw[None, :] > tq[:, None] - WIN)
        s = jnp.einsum('bqgrd,bkgd->bgrqk', qc, kw) * scale
        o_win = jnp.einsum('bgrqk,bkgd->bqgrd', masked_softmax(s, wmask), vw)
        o = gc[..., 0:1] * o_cmp + gc[..., 1:2] * o_slc + gc[..., 2:3] * o_win
        return o.reshape(B, Q_BLOCK, G * R * D).astype(q.dtype)

    out = lax.map(block, jnp.arange(S // Q_BLOCK))
    return out.transpose(1, 0, 2, 3).reshape(B, S, G * R * D)


def dsa_mixer(q, k, v, q_idx, k_idx, w_idx):
    B, S = q.shape[:2]
    G, R, D = DSA_KV_HEADS, DSA_HPG, HEAD_DIM
    scale = D ** -0.5
    n_keep = min(IDX_TOPK_MAX, S // 4)
    kk = k.reshape(B, S, G, D)
    vv = v.reshape(B, S, G, D)
    qi_all = q_idx.reshape(B, S, IDX_HEADS, IDX_DIM)
    kpos = jnp.arange(S)
    b_i = jnp.arange(B)[:, None, None]

    def block(ib):
        t0 = ib * Q_BLOCK
        tq = t0 + jnp.arange(Q_BLOCK)
        qi = lax.dynamic_slice_in_dim(qi_all, t0, Q_BLOCK, axis=1)
        wi = lax.dynamic_slice_in_dim(w_idx, t0, Q_BLOCK, axis=1)
        sc = jax.nn.relu(jnp.einsum('bqhd,bsd->bqhs', qi, k_idx) * IDX_DIM ** -0.5)
        idx_score = jnp.einsum('bqhs,bqh->bqs', sc.astype(jnp.float32), wi.astype(jnp.float32)) * IDX_HEADS ** -0.5
        idx_score = jnp.where(kpos[None, :] <= tq[:, None], idx_score, -jnp.inf)
        _, sel = lax.top_k(idx_score, n_keep)
        kg = kk[b_i, sel]
        vg = vv[b_i, sel]
        qc = lax.dynamic_slice_in_dim(q, t0, Q_BLOCK, axis=1).reshape(B, Q_BLOCK, G, R, D)
        s = jnp.einsum('bqgrd,bqkgd->bgrqk', qc, kg) * scale
        mask = (sel <= tq[None, :, None])[:, None, None]
        o = jnp.einsum('bgrqk,bqkgd->bqgrd', masked_softmax(s, mask), vg)
        return o.reshape(B, Q_BLOCK, G * R * D).astype(q.dtype)

    out = lax.map(block, jnp.arange(S // Q_BLOCK))
    return out.transpose(1, 0, 2, 3).reshape(B, S, G * R * D)


def layer_ab(x, c, norm_mix, norm_ffn, mod_w, mod_b, w_in, conv_w, conv_b, wa, ba, wx, bx, lam,
             pe_k, w1_k, w2_k, pe_v, w1_v, w2_v, w_out, wg, wu, wd):
    sh_m, sc_m, g_m, sh_f, sc_f, g_f = adaln(c, mod_w, mod_b)
    h = modulate(x, norm_mix, sh_m, sc_m)
    (a_gate, a_x, q, kc, vc, ks, vs, kw, vw, gts) = _split(h @ w_in, IN0_SIZES)
    y_a = rg_lru(causal_conv(a_x, conv_w, conv_b), wa, ba, wx, bx, lam) * jax.nn.gelu(a_gate)
    y_b = nsa_mixer(q, kc, vc, ks, vs, kw, vw, jax.nn.sigmoid(gts), pe_k, w1_k, w2_k, pe_v, w1_v, w2_v)
    x = x + g_m[:, None, :] * (jnp.concatenate([y_a, y_b], axis=-1) @ w_out)
    h = modulate(x, norm_ffn, sh_f, sc_f)
    return x + g_f[:, None, :] * swiglu(h, wg, wu, wd)


def layer_c(x, c, norm_mix, norm_ffn, mod_w, mod_b, w_in, w_out, wg, wu, wd):
    sh_m, sc_m, g_m, sh_f, sc_f, g_f = adaln(c, mod_w, mod_b)
    h = modulate(x, norm_mix, sh_m, sc_m)
    q, k, v, q_idx, k_idx, w_idx = _split(h @ w_in, IN1_SIZES)
    x = x + g_m[:, None, :] * (dsa_mixer(q, k, v, q_idx, k_idx, w_idx) @ w_out)
    h = modulate(x, norm_ffn, sh_f, sc_f)
    return x + g_f[:, None, :] * swiglu(h, wg, wu, wd)


def setup_inputs(seed: int = 0) -> dict:
    key = jax.random.key(seed)
    keys = iter(jax.random.split(key, 64))

    def nrm(shape, s):
        return jax.random.normal(next(keys), shape, jnp.float32) * s

    def gain(n):
        return 1.0 + nrm((n,), 0.05)

    D = D_MODEL
    a0 = jax.random.uniform(next(keys), (LRU_WIDTH,), jnp.float32, minval=0.9, maxval=0.999)
    r0 = a0 ** (1.0 / LRU_C)
    lam = jnp.log(r0) - jnp.log1p(-r0)
    return {
        "x": nrm((BATCH, SEQ, D), 1.0),
        "c": nrm((BATCH, D), 1.0),
        "l0_norm_mix": gain(D),
        "l0_norm_ffn": gain(D),
        "l0_mod_w": nrm((D, 6 * D), 0.5 * D ** -0.5),
        "l0_mod_b": nrm((6 * D,), 0.01),
        "l0_w_in": nrm((D, IN0), D ** -0.5),
        "l0_conv_w": nrm((CONV_WIDTH, LRU_WIDTH), CONV_WIDTH ** -0.5),
        "l0_conv_b": nrm((LRU_WIDTH,), 0.01),
        "l0_lru_wa": nrm((LRU_BLOCKS, LRU_BLOCK, LRU_BLOCK), LRU_BLOCK ** -0.5),
        "l0_lru_ba": nrm((LRU_WIDTH,), 0.01),
        "l0_lru_wx": nrm((LRU_BLOCKS, LRU_BLOCK, LRU_BLOCK), LRU_BLOCK ** -0.5),
        "l0_lru_bx": nrm((LRU_WIDTH,), 0.01),
        "l0_lru_lambda": lam,
        "l0_cmp_pe_k": nrm((CMP_LEN, HEAD_DIM), 0.5),
        "l0_cmp_w1_k": nrm((CMP_LEN * HEAD_DIM, CMP_HIDDEN), (CMP_LEN * HEAD_DIM) ** -0.5),
        "l0_cmp_w2_k": nrm((CMP_HIDDEN, HEAD_DIM), CMP_HIDDEN ** -0.5),
        "l0_cmp_pe_v": nrm((CMP_LEN, HEAD_DIM), 0.5),
        "l0_cmp_w1_v": nrm((CMP_LEN * HEAD_DIM, CMP_HIDDEN), (CMP_LEN * HEAD_DIM) ** -0.5),
        "l0_cmp_w2_v": nrm((CMP_HIDDEN, HEAD_DIM), CMP_HIDDEN ** -0.5),
        "l0_w_out": nrm((MIX0, D), MIX0 ** -0.5),
        "l0_ffn_wg": nrm((D, D_FF), D ** -0.5),
        "l0_ffn_wu": nrm((D, D_FF), D ** -0.5),
        "l0_ffn_wd": nrm((D_FF, D), D_FF ** -0.5),
        "l1_norm_mix": gain(D),
        "l1_norm_ffn": gain(D),
        "l1_mod_w": nrm((D, 6 * D), 0.5 * D ** -0.5),
        "l1_mod_b": nrm((6 * D,), 0.01),
        "l1_w_in": nrm((D, IN1), D ** -0.5),
        "l1_w_out": nrm((MIX1, D), MIX1 ** -0.5),
        "l1_ffn_wg": nrm((D, D_FF), D ** -0.5),
        "l1_ffn_wu": nrm((D, D_FF), D ** -0.5),
        "l1_ffn_wd": nrm((D_FF, D), D_FF ** -0.5),
        "final_norm": gain(D),
    }


def reference(x, c,
              l0_norm_mix, l0_norm_ffn, l0_mod_w, l0_mod_b, l0_w_in, l0_conv_w, l0_conv_b,
              l0_lru_wa, l0_lru_ba, l0_lru_wx, l0_lru_bx, l0_lru_lambda,
              l0_cmp_pe_k, l0_cmp_w1_k, l0_cmp_w2_k, l0_cmp_pe_v, l0_cmp_w1_v, l0_cmp_w2_v,
              l0_w_out, l0_ffn_wg, l0_ffn_wu, l0_ffn_wd,
              l1_norm_mix, l1_norm_ffn, l1_mod_w, l1_mod_b, l1_w_in, l1_w_out,
              l1_ffn_wg, l1_ffn_wu, l1_ffn_wd,
              final_norm):
    layer_params = [
        (l0_norm_mix, l0_norm_ffn, l0_mod_w, l0_mod_b, l0_w_in, l0_conv_w, l0_conv_b,
         l0_lru_wa, l0_lru_ba, l0_lru_wx, l0_lru_bx, l0_lru_lambda,
         l0_cmp_pe_k, l0_cmp_w1_k, l0_cmp_w2_k, l0_cmp_pe_v, l0_cmp_w1_v, l0_cmp_w2_v,
         l0_w_out, l0_ffn_wg, l0_ffn_wu, l0_ffn_wd),
        (l1_norm_mix, l1_norm_ffn, l1_mod_w, l1_mod_b, l1_w_in, l1_w_out,
         l1_ffn_wg, l1_ffn_wu, l1_ffn_wd),
    ]
    for layer in range(DEPTH):
        if layer % 2 == 0:
            x = layer_ab(x, c, *layer_params[layer])
        else:
            x = layer_c(x, c, *layer_params[layer])
    return rmsnorm(x, final_norm)
```

```cpp
#include <hip/hip_runtime.h>
#include <hip/hip_cooperative_groups.h>
#include <cstdio>
#include <cstdint>
namespace cg = cooperative_groups;
namespace pg8 {
#define PG8_LAS __attribute__((address_space(3)))
typedef unsigned short bf16_t;
typedef short bf16x8 __attribute__((ext_vector_type(8)));
typedef float f32x4 __attribute__((ext_vector_type(4)));
typedef unsigned u32x4 __attribute__((ext_vector_type(4)));
constexpr int BM = 256, BK = 64, HALF = 128, HTB = HALF * BK * 2  , STAGE_BYTES = 8 * HTB, NXCD = 8, WGM = 8;

__host__ __device__ __forceinline__ int lds_byte(int r, int c) { const int st = (r >> 4) * 2 + (c >> 5), rr = r & 15, cc = c & 31, ob = rr * 64 + cc * 2; return st * 1024 + (ob ^ (((ob >> 9) & 1) << 5)); }
__host__ __device__ __forceinline__ void stage_rc(int b, int& R, int& C) { const int st = b / 1024, sb = b % 1024, swz = sb ^ (((sb >> 9) & 1) << 5); R = (st >> 1) * 16 + swz / 64; C = (st & 1) * 32 + (swz % 64) / 2; }
__host__ __device__ __forceinline__ int perm32(int rho) { const int n = rho >> 4, i = rho & 15; return 8 * (i >> 2) + 4 * n + (i & 3); }

struct Unit { int pm, pn; };
struct Gemm { const bf16_t* A; const bf16_t* Bt; int M, N, K; };

struct StaticOrder {
    int nM, nN, nwg, G, c;
    __host__ __device__ void init(int M, int N, int G_, int c_) { nM = M / BM; nN = N / BM; nwg = nM * nN; G = G_; c = c_; }
    __host__ __device__ bool next(int i, Unit& u) const {
        const long L = (long)i * G + c; if (L >= nwg) return false;
        int wgid = (int)L; { const int q = nwg / NXCD, r = nwg % NXCD, xcd = wgid % NXCD, off = wgid / NXCD; wgid = (xcd < r ? xcd * (q + 1) : r * (q + 1) + (xcd - r) * q) + off; }
        const int nig = WGM * nN, gid = wgid / nig, fm = gid * WGM, gsz = (nM - fm) < WGM ? (nM - fm) : WGM;
        u.pm = fm + ((wgid % nig) % gsz); u.pn = (wgid % nig) / gsz; return true;
    }
    __device__ __forceinline__ void a_ready(const Unit&) const {}
    __device__ __forceinline__ void done(const Unit&) const {}
};


typedef float f32x2v __attribute__((ext_vector_type(2)));
typedef __bf16 bf16x2v __attribute__((ext_vector_type(2)));
typedef unsigned u32x2 __attribute__((ext_vector_type(2)));
__device__ __forceinline__ unsigned cvt_pk_bf16(float lo, float hi) { f32x2v v = {lo, hi}; bf16x2v b = __builtin_convertvector(v, bf16x2v); return __builtin_bit_cast(unsigned, b); }

struct EpiStoreBf16 {
    static constexpr bool PERM = true, AFTER_DRAIN = false;
    bf16_t* O; int ldc;
    __device__ __forceinline__ void operator()(const f32x4 (&acc)[2][2][4][2], const Unit& u, int wr, int wc, int fr, int fq) const {
        const int row0 = u.pm * BM + wr * 64 + fr, col0 = u.pn * BM + wc * 32 + 8 * fq;
#pragma unroll
        for (int ai = 0; ai < 2; ++ai)
#pragma unroll
            for (int m = 0; m < 4; ++m) { bf16_t* rowp = O + (size_t)(row0 + ai * HALF + m * 16) * ldc + col0;
#pragma unroll
                for (int bj = 0; bj < 2; ++bj) { const f32x4 v0 = acc[ai][bj][m][0], v1 = acc[ai][bj][m][1];
                    u32x4 w; w.x = cvt_pk_bf16(v0[0], v0[1]); w.y = cvt_pk_bf16(v0[2], v0[3]); w.z = cvt_pk_bf16(v1[0], v1[1]); w.w = cvt_pk_bf16(v1[2], v1[3]);
                    *(u32x4*)(rowp + bj * HALF) = w; } }
    }
};
struct EpiResGate {
    static constexpr bool PERM = false, AFTER_DRAIN = false;
    const float* res; float* out; const float* gate; int gpitch;
    __device__ __forceinline__ void operator()(const f32x4 (&acc)[2][2][4][2], const Unit& u, int wr, int wc, int fr, int fq) const {
        const int row0 = u.pm * BM + wr * 64 + fr, col0 = u.pn * BM + wc * 32 + 4 * fq;
        const float* gp = gate + (size_t)(u.pm >> 3) * gpitch + col0;
        f32x4 gv[2][2];
#pragma unroll
        for (int bj = 0; bj < 2; ++bj)
#pragma unroll
            for (int n = 0; n < 2; ++n) gv[bj][n] = *(const f32x4*)(gp + bj * HALF + n * 16);
#pragma unroll
        for (int ai = 0; ai < 2; ++ai)
#pragma unroll
            for (int m = 0; m < 4; ++m) { const size_t off = (size_t)(row0 + ai * HALF + m * 16) * 1024 + col0;
#pragma unroll
                for (int bj = 0; bj < 2; ++bj)
#pragma unroll
                    for (int n = 0; n < 2; ++n) { const f32x4 r = *(const f32x4*)(res + off + bj * HALF + n * 16);
                        *(f32x4*)(out + off + bj * HALF + n * 16) = r + gv[bj][n] * acc[ai][bj][m][n]; } }
    }
};
struct EpiSwiGLU {
    static constexpr bool PERM = true, AFTER_DRAIN = false;
    bf16_t* O; int ldc;
    __device__ __forceinline__ void operator()(const f32x4 (&acc)[2][2][4][2], const Unit& u, int wr, int wc, int fr, int fq) const {
        const int row0 = u.pm * BM + wr * 64 + fr, col0 = u.pn * (BM / 2) + wc * 16 + 4 * fq;
#pragma unroll
        for (int ai = 0; ai < 2; ++ai)
#pragma unroll
            for (int m = 0; m < 4; ++m) { bf16_t* rowp = O + (size_t)(row0 + ai * HALF + m * 16) * ldc + col0;
#pragma unroll
                for (int bj = 0; bj < 2; ++bj) { const f32x4 g = acc[ai][bj][m][0], up = acc[ai][bj][m][1]; f32x4 o;
#pragma unroll
                    for (int e = 0; e < 4; ++e) o[e] = g[e] * up[e] / (1.0f + __expf(-g[e]));
                    u32x2 w; w.x = cvt_pk_bf16(o[0], o[1]); w.y = cvt_pk_bf16(o[2], o[3]);
                    *(u32x2*)(rowp + bj * (HALF / 2)) = w; } }
    }
};
template <class Epi, class Sched, bool ALIGN_EPI = false, bool SP2 = false>
__device__ __forceinline__ void gemm_phase(PG8_LAS unsigned char* lds, const Gemm g, const Sched& S, const Epi& E) {
    const int tid = threadIdx.x, wid = __builtin_amdgcn_readfirstlane(tid >> 6), lane = tid & 63, wr = wid >> 2, wc = wid & 3, fr = lane & 15, fq = lane >> 4;
    const int K = g.K, nt = K / BK;
    unsigned voffA[2], voffB[2];
#pragma unroll
    for (int i = 0; i < 2; ++i) { int R, C; stage_rc(tid * 16 + i * 8192, R, C); const int Rb = Epi::PERM ? ((R & ~31) + perm32(R & 31)) : R;
        voffA[i] = (unsigned)(R * K + C) * 2u; voffB[i] = (unsigned)(Rb * K + C) * 2u; }
    const size_t kstep = (size_t)(BK * 2);
    const size_t hstep = (size_t)HALF * K * 2;
    const size_t tstep = 2 * hstep;
    const unsigned ldsw = (unsigned)wid * 1024u;
    const int aoff = lds_byte(wr * 64 + fr, fq * 8), boff = lds_byte(wc * 32 + fr, fq * 8);
#define PG8_SA(b, h) (((b) * 2 + (h)) * HTB)
#define PG8_SB(b, h) ((4 + (b) * 2 + (h)) * HTB)
#define PG8_STAGE(bufoff, gbase, voff) do { _Pragma("unroll") for (int _i = 0; _i < 2; ++_i) \
        __builtin_amdgcn_global_load_lds((const unsigned*)((const char*)(gbase) + (voff)[_i]), (PG8_LAS unsigned*)(lds + (bufoff) + ldsw + _i * 8192), 16, 0, 0); } while (0)
#define PG8_LDA(dst, b, h) do { _Pragma("unroll") for (int m = 0; m < 4; ++m) _Pragma("unroll") for (int k = 0; k < 2; ++k) dst[m][k] = *(const PG8_LAS bf16x8*)(lds + PG8_SA(b, h) + aoff + m * 2048 + k * 1024); } while (0)
#define PG8_LDB(dst, b, h) do { _Pragma("unroll") for (int n = 0; n < 2; ++n) _Pragma("unroll") for (int k = 0; k < 2; ++k) dst[n][k] = *(const PG8_LAS bf16x8*)(lds + PG8_SB(b, h) + boff + n * 2048 + k * 1024); } while (0)
#define PG8_MMA(ai, bj, At, Bt) do { __builtin_amdgcn_s_setprio(1); _Pragma("unroll") for (int m = 0; m < 4; ++m) _Pragma("unroll") for (int n = 0; n < 2; ++n) _Pragma("unroll") for (int k = 0; k < 2; ++k) \
        acc[ai][bj][m][n] = __builtin_amdgcn_mfma_f32_16x16x32_bf16(Bt[n][k], At[m][k], acc[ai][bj][m][n], 0, 0, 0); __builtin_amdgcn_s_setprio(0); } while (0)
#define PG8_WAIT_V(n) asm volatile("s_waitcnt vmcnt(" #n ")" ::: "memory")
#define PG8_WAIT_L(n) asm volatile("s_waitcnt lgkmcnt(" #n ")" ::: "memory")
#define PG8_BAR __builtin_amdgcn_s_barrier()
#define PG8_SCHED __builtin_amdgcn_sched_barrier(0)
    Unit cur, nxt; int ui = 0;
    if (!S.next(0, cur)) return;
    f32x4 acc[2][2][4][2];
#pragma unroll
    for (int a = 0; a < 2; ++a)
#pragma unroll
        for (int b = 0; b < 2; ++b)
#pragma unroll
            for (int m = 0; m < 4; ++m)
#pragma unroll
                for (int n = 0; n < 2; ++n) acc[a][b][m][n] = (f32x4){0.f, 0.f, 0.f, 0.f};
    bf16x8 At[4][2], B0[2][2], B1[2][2];
    const char* cA = (const char*)g.A + (size_t)cur.pm * tstep; const char* cB = (const char*)g.Bt + (size_t)cur.pn * tstep;
    S.a_ready(cur);
    if constexpr (SP2) {
        PG8_STAGE(PG8_SB(0, 0), cB, voffB); PG8_STAGE(PG8_SB(0, 1), cB + hstep, voffB); PG8_STAGE(PG8_SA(0, 0), cA, voffA); PG8_STAGE(PG8_SA(0, 1), cA + hstep, voffA);
        if (wr == 1) PG8_BAR;
        PG8_WAIT_V(2); PG8_BAR;
        PG8_STAGE(PG8_SB(1, 0), cB + kstep, voffB); PG8_STAGE(PG8_SA(1, 0), cA + kstep, voffA); PG8_STAGE(PG8_SB(1, 1), cB + hstep + kstep, voffB);
        PG8_WAIT_V(6); PG8_BAR;
    } else {
        PG8_STAGE(PG8_SB(0, 0), cB, voffB); PG8_STAGE(PG8_SA(0, 0), cA, voffA); PG8_STAGE(PG8_SB(0, 1), cB + hstep, voffB); PG8_STAGE(PG8_SA(0, 1), cA + hstep, voffA);
        if (wr == 1) PG8_BAR;
        PG8_WAIT_V(4); PG8_BAR;
        PG8_STAGE(PG8_SB(1, 0), cB + kstep, voffB); PG8_STAGE(PG8_SA(1, 0), cA + kstep, voffA); PG8_STAGE(PG8_SB(1, 1), cB + hstep + kstep, voffB);
        PG8_WAIT_V(6); PG8_BAR;
    }
    for (;;) {
        const bool has_next = S.next(ui + 1, nxt);
        const char* nA = has_next ? (const char*)g.A + (size_t)nxt.pm * tstep : cA; const char* nB = has_next ? (const char*)g.Bt + (size_t)nxt.pn * tstep : cB;
        for (int t = 0; t < nt; t += 2) {
            const bool last = (t == nt - 2);
            const char* a1 = cA + (size_t)(t + 1) * kstep;
            const char* a2 = last ? nA : cA + (size_t)(t + 2) * kstep; const char* b2 = last ? nB : cB + (size_t)(t + 2) * kstep;
            const char* a3 = a2 + kstep; const char* b3 = b2 + kstep;
            if (last && has_next) S.a_ready(nxt);
            if constexpr (SP2) {
            PG8_LDB(B0, 0, 0); PG8_LDB(B1, 0, 1); PG8_SCHED; PG8_LDA(At, 0, 0); PG8_STAGE(PG8_SA(1, 1), a1 + hstep, voffA);
            PG8_WAIT_V(8); PG8_WAIT_L(0); PG8_BAR; PG8_MMA(0, 0, At, B0); PG8_MMA(0, 1, At, B1); PG8_BAR; PG8_SCHED;
            PG8_LDA(At, 0, 1); PG8_STAGE(PG8_SB(0, 0), b2, voffB); PG8_STAGE(PG8_SB(0, 1), b2 + hstep, voffB); PG8_STAGE(PG8_SA(0, 0), a2, voffA);
            PG8_WAIT_V(8); PG8_WAIT_L(0); PG8_BAR; PG8_MMA(1, 0, At, B0); PG8_MMA(1, 1, At, B1); PG8_BAR; PG8_SCHED;
            PG8_LDB(B0, 1, 0); PG8_LDB(B1, 1, 1); PG8_SCHED; PG8_LDA(At, 1, 0); PG8_STAGE(PG8_SA(0, 1), a2 + hstep, voffA);
            PG8_WAIT_V(8); PG8_WAIT_L(0); PG8_BAR; PG8_MMA(0, 0, At, B0); PG8_MMA(0, 1, At, B1); PG8_BAR; PG8_SCHED;
            PG8_LDA(At, 1, 1); PG8_STAGE(PG8_SB(1, 0), b3, voffB); PG8_STAGE(PG8_SB(1, 1), b3 + hstep, voffB); PG8_STAGE(PG8_SA(1, 0), a3, voffA);
            PG8_WAIT_V(8); PG8_WAIT_L(0); PG8_BAR; PG8_MMA(1, 0, At, B0); PG8_MMA(1, 1, At, B1); PG8_BAR; PG8_SCHED;
            } else {
            PG8_LDB(B0, 0, 0); PG8_SCHED; PG8_LDA(At, 0, 0); PG8_STAGE(PG8_SA(1, 1), a1 + hstep, voffA);
            PG8_WAIT_L(8); PG8_BAR; PG8_WAIT_L(0); PG8_MMA(0, 0, At, B0); PG8_BAR; PG8_SCHED;
            PG8_LDB(B1, 0, 1); PG8_STAGE(PG8_SB(0, 0), b2, voffB);
            PG8_BAR; PG8_WAIT_L(0); PG8_MMA(0, 1, At, B1); PG8_BAR;
            PG8_LDA(At, 0, 1); PG8_STAGE(PG8_SA(0, 0), a2, voffA);
            PG8_BAR; PG8_WAIT_L(0); PG8_MMA(1, 0, At, B0); PG8_BAR; PG8_SCHED;
            PG8_STAGE(PG8_SB(0, 1), b2 + hstep, voffB);
            PG8_WAIT_V(6); PG8_BAR; PG8_MMA(1, 1, At, B1); PG8_BAR;
            PG8_LDB(B0, 1, 0); PG8_SCHED; PG8_LDA(At, 1, 0); PG8_STAGE(PG8_SA(0, 1), a2 + hstep, voffA);
            PG8_WAIT_L(8); PG8_BAR; PG8_WAIT_L(0); PG8_MMA(0, 0, At, B0); PG8_BAR; PG8_SCHED;
            PG8_LDB(B1, 1, 1); PG8_STAGE(PG8_SB(1, 0), b3, voffB);
            PG8_BAR; PG8_WAIT_L(0); PG8_MMA(0, 1, At, B1); PG8_BAR;
            PG8_LDA(At, 1, 1); PG8_STAGE(PG8_SA(1, 0), a3, voffA);
            PG8_BAR; PG8_WAIT_L(0); PG8_MMA(1, 0, At, B0); PG8_BAR; PG8_SCHED;
            PG8_STAGE(PG8_SB(1, 1), b3 + hstep, voffB);
            PG8_WAIT_V(6); PG8_BAR; PG8_MMA(1, 1, At, B1); PG8_BAR;
            }
        }
        if constexpr (ALIGN_EPI) { if (wr == 0) PG8_BAR; }
        if constexpr (!Epi::AFTER_DRAIN) { E(acc, cur, wr, wc, fr, fq); S.done(cur); }
        if (!has_next) break;
#pragma unroll
        for (int a = 0; a < 2; ++a)
#pragma unroll
            for (int b = 0; b < 2; ++b)
#pragma unroll
                for (int m = 0; m < 4; ++m)
#pragma unroll
                    for (int n = 0; n < 2; ++n) acc[a][b][m][n] = (f32x4){0.f, 0.f, 0.f, 0.f};
        cur = nxt; cA = nA; cB = nB; ++ui;
        if constexpr (ALIGN_EPI) { if (wr == 1) PG8_BAR; }
    }
    PG8_WAIT_V(0);
    if constexpr (!ALIGN_EPI) { if (wr == 0) PG8_BAR; }
    PG8_BAR;
    if constexpr (Epi::AFTER_DRAIN) { E.fused(acc, cur, wr, wc, fr, fq, lds, wid, lane); S.done(cur); }
#undef PG8_SA
#undef PG8_SB
#undef PG8_STAGE
#undef PG8_LDA
#undef PG8_LDB
#undef PG8_MMA
#undef PG8_WAIT_V
#undef PG8_WAIT_L
#undef PG8_BAR
#undef PG8_SCHED
}
}

constexpr int NB = 16, SEQ = 2048, DM = 1024, MROWS = NB * SEQ;
constexpr int IN0P = 2560, IN1P = 2048, IN0 = 2328, IN1 = 1864, DFF = 2816;
constexpr int NTHR = 512, NWV = 8;
constexpr int C_AGATE = 0, C_AX = 512, C_Q = 1024, C_KC = 1536, C_VC = 1664, C_KS = 1792, C_VS = 1920, C_KW = 2048, C_VW = 2176, C_GT = 2304;
constexpr int D_Q = 0, D_K = 1024, D_V = 1152, D_QI = 1280, D_KI = 1792, D_WI = 1856;

constexpr size_t MiB = 1u << 20;
constexpr size_t WS_MOD0 = 64 * 1024, WS_MOD1 = WS_MOD0 + 16 * 6144 * 4, WS_CB1 = WS_MOD1 + 16 * 6144 * 4;
constexpr size_t WS_WIN0 = 4 * MiB, WS_WOUT0 = 9 * MiB, WS_WGU0 = 11 * MiB, WS_WD0 = 22 * MiB;
constexpr size_t WS_WIN1 = 28 * MiB, WS_WOUT1 = 32 * MiB, WS_WGU1 = 34 * MiB, WS_WD1 = 45 * MiB;
constexpr size_t WS_CW1K = 51 * MiB, WS_CW1V = WS_CW1K + 512 * 1024, WS_CW2K = 52 * MiB, WS_CW2V = WS_CW2K + 64 * 1024, WS_WAT = WS_CW2V + 64 * 1024, WS_WXT = WS_WAT + 64 * 1024;
constexpr size_t WS_XN = 56 * MiB;
constexpr size_t WS_BIG = 120 * MiB;
constexpr size_t WS_Y = 296 * MiB;
constexpr size_t WS_HL = 360 * MiB;
constexpr size_t WS_PC = 424 * MiB;
constexpr size_t WS_KC = 488 * MiB, WS_VC = WS_KC + 512 * 1024;
constexpr size_t WS_MASK = 489 * MiB;
constexpr size_t WS_END = 497 * MiB;

constexpr int LDS_BYTES = 147456;

#define LAS __attribute__((address_space(3)))
typedef unsigned short bf16;
typedef short bf16x8 __attribute__((ext_vector_type(8)));
typedef short s16x4 __attribute__((ext_vector_type(4)));
typedef float f32x4 __attribute__((ext_vector_type(4)));
typedef float f32x16 __attribute__((ext_vector_type(16)));
typedef unsigned u32x4 __attribute__((ext_vector_type(4)));
typedef unsigned u32x2 __attribute__((ext_vector_type(2)));
#define DI __device__ __forceinline__
#define MFMA32(a, b, c) __builtin_amdgcn_mfma_f32_32x32x16_bf16((a), (b), (c), 0, 0, 0)

DI unsigned pk2(float lo, float hi) { return pg8::cvt_pk_bf16(lo, hi); }
DI bf16 f2bf(float f) { return (bf16)(pk2(f, 0.f) & 0xffffu); }
DI float bf2f(bf16 u) { return __uint_as_float((unsigned)u << 16); }
DI int crow(int r, int hi) { return (r & 3) + 8 * (r >> 2) + 4 * hi; }
DI float sigmoidf_(float x) { return 1.0f / (1.0f + __expf(-x)); }
DI float gelu_tanh(float x) { const float z = 0.7978845608028654f * (x + 0.044715f * x * x * x); return x * sigmoidf_(2.0f * z); }
DI float wave_sum(float v) {
#pragma unroll
    for (int o = 1; o < 64; o <<= 1) v += __shfl_xor(v, o);
    return v;
}
DI s16x4 vtr(const LAS char* p) { typedef short v4i16_t __attribute__((ext_vector_type(4))); return __builtin_bit_cast(s16x4, __builtin_amdgcn_ds_read_tr16_b64_v4i16((LAS v4i16_t*)p)); }

DI int opaque(int v) { asm volatile("" : "+v"(v)); return v; }
struct Args { const float* in[34]; float* out; unsigned char* ws; };

struct Frame {
    LAS unsigned char* lds;
    int tid, lane, wave, G, bid;
    const float* const* in;
    float* out; unsigned char* ws;
};

template <int MODE  >
DI void transpose_item(const float* W, int K, int N, bf16* WT, int row_off, LAS float* scr, int item, int lane) {
    const int nblk = (N + 31) / 32, kb = item / nblk, nb = item % nblk, k0 = 64 * kb, n0 = 32 * nb;
    const int nn = n0 + (lane & 31);
#pragma unroll 8
    for (int i = 0; i < 32; ++i) { const int kk = 2 * i + (lane >> 5); scr[kk * 33 + (lane & 31)] = (nn < N) ? W[(size_t)(k0 + kk) * N + nn] : 0.f; }
    asm volatile("s_waitcnt lgkmcnt(0)" ::: "memory");
    const int c = lane & 7;
#pragma unroll
    for (int j = 0; j < 4; ++j) { const int n = (lane >> 3) + 8 * j; const LAS float* s = scr + (8 * c) * 33 + n;
        u32x4 o; o.x = pk2(s[0 * 33], s[1 * 33]); o.y = pk2(s[2 * 33], s[3 * 33]); o.z = pk2(s[4 * 33], s[5 * 33]); o.w = pk2(s[6 * 33], s[7 * 33]);
        const int ng = n0 + n;
        int dr;
        if (MODE == 0) dr = row_off + ng; else if (MODE == 1) dr = (ng >> 2) * 8 + (ng & 3); else dr = (ng >> 2) * 8 + 4 + (ng & 3);
        if (ng < N) *(u32x4*)(WT + (size_t)dr * K + k0 + 8 * c) = o; }
    asm volatile("s_waitcnt lgkmcnt(0)" ::: "memory");
}

DI void p0_adaln_item(Frame& F, int it) {
    const int l = it / 96, n0 = 64 * (it % 96);
    const float* c = F.in[1]; const float* W = F.in[l ? 26 : 4]; const float* bias = F.in[l ? 27 : 5];
    float* MOD = (float*)(F.ws + (l ? WS_MOD1 : WS_MOD0));
    LAS float* scT = (LAS float*)F.lds;
    LAS float* red = (LAS float*)(F.lds + 65536);
    for (int e = F.tid; e < 16 * 1024; e += NTHR) { const int b = e >> 10, k = e & 1023; const float v = c[e]; scT[k * 16 + b] = v * sigmoidf_(v); }
    __syncthreads();
    const int col = F.tid & 63, kg = F.tid >> 6;
    float acc[16];
#pragma unroll
    for (int b = 0; b < 16; ++b) acc[b] = 0.f;
    for (int k = kg * 128; k < kg * 128 + 128; ++k) {
        const float w = W[(size_t)k * 6144 + n0 + col];
        const LAS f32x4* sp = (const LAS f32x4*)(scT + k * 16);
#pragma unroll
        for (int q = 0; q < 4; ++q) { const f32x4 s = sp[q]; acc[4 * q + 0] += s[0] * w; acc[4 * q + 1] += s[1] * w; acc[4 * q + 2] += s[2] * w; acc[4 * q + 3] += s[3] * w; }
    }
#pragma unroll
    for (int b = 0; b < 16; ++b) red[(kg * 16 + b) * 64 + col] = acc[b];
    __syncthreads();
    for (int o = F.tid; o < 1024; o += NTHR) { const int b = o >> 6, cc = o & 63; float s = 0.f;
#pragma unroll
        for (int g = 0; g < 8; ++g) s += red[(g * 16 + b) * 64 + cc];
        MOD[b * 6144 + n0 + cc] = s + bias[n0 + cc]; }
    __syncthreads();
}
DI void p0_cb1_item(Frame& F, int it) {
    const int kv = it >> 1, n0 = 64 * (it & 1);
    const float* pe = F.in[kv ? 17 : 14]; const float* W = F.in[kv ? 18 : 15];
    float* CB1 = (float*)(F.ws + WS_CB1);
    LAS float* red = (LAS float*)F.lds;
    const int col = F.tid & 63, kg = F.tid >> 6;
    float acc = 0.f;
    for (int k = kg * 256; k < kg * 256 + 256; ++k) acc += pe[k] * W[(size_t)k * 128 + n0 + col];
    red[kg * 64 + col] = acc;
    __syncthreads();
    if (F.tid < 64) { float s = 0.f;
#pragma unroll
        for (int g = 0; g < 8; ++g) s += red[g * 64 + F.tid];
        CB1[kv * 128 + n0 + F.tid] = s; }
    __syncthreads();
}
DI void p0_prologue(Frame& F) {
    for (int it = F.bid; it < 196; it += F.G) { if (it < 192) p0_adaln_item(F, it); else p0_cb1_item(F, it - 192); }
    __syncthreads();
    LAS float* scr = (LAS float*)(F.lds + F.wave * 16384);
    const int gw = F.bid * NWV + F.wave, NGW = F.G * NWV;
    unsigned char* ws = F.ws;
    constexpr int I_WIN0 = 16 * 73, I_SQ = 16 * 32, I_FF = 16 * 88, I_WD = 44 * 32, I_WIN1 = 16 * 59, I_C1 = 32 * 4, I_C2 = 2 * 2, I_LR = 8 * 2;
    constexpr int NITEMS = I_WIN0 + I_SQ + 2 * I_FF + I_WD + I_WIN1 + I_SQ + 2 * I_FF + I_WD + 2 * I_C1 + 2 * I_C2 + 2 * I_LR;
    for (int it = gw; it < NITEMS; it += NGW) {
        int r = it;
        if (r < I_WIN0) { transpose_item<0>(F.in[6], 1024, IN0, (bf16*)(ws + WS_WIN0), 0, scr, r, F.lane); continue; } r -= I_WIN0;
        if (r < I_SQ) { transpose_item<0>(F.in[20], 1024, 1024, (bf16*)(ws + WS_WOUT0), 0, scr, r, F.lane); continue; } r -= I_SQ;
        if (r < I_FF) { transpose_item<1>(F.in[21], 1024, DFF, (bf16*)(ws + WS_WGU0), 0, scr, r, F.lane); continue; } r -= I_FF;
        if (r < I_FF) { transpose_item<2>(F.in[22], 1024, DFF, (bf16*)(ws + WS_WGU0), 0, scr, r, F.lane); continue; } r -= I_FF;
        if (r < I_WD) { transpose_item<0>(F.in[23], DFF, 1024, (bf16*)(ws + WS_WD0), 0, scr, r, F.lane); continue; } r -= I_WD;
        if (r < I_WIN1) { transpose_item<0>(F.in[28], 1024, IN1, (bf16*)(ws + WS_WIN1), 0, scr, r, F.lane); continue; } r -= I_WIN1;
        if (r < I_SQ) { transpose_item<0>(F.in[29], 1024, 1024, (bf16*)(ws + WS_WOUT1), 0, scr, r, F.lane); continue; } r -= I_SQ;
        if (r < I_FF) { transpose_item<1>(F.in[30], 1024, DFF, (bf16*)(ws + WS_WGU1), 0, scr, r, F.lane); continue; } r -= I_FF;
        if (r < I_FF) { transpose_item<2>(F.in[31], 1024, DFF, (bf16*)(ws + WS_WGU1), 0, scr, r, F.lane); continue; } r -= I_FF;
        if (r < I_WD) { transpose_item<0>(F.in[32], DFF, 1024, (bf16*)(ws + WS_WD1), 0, scr, r, F.lane); continue; } r -= I_WD;
        if (r < I_C1) { transpose_item<0>(F.in[15], 2048, 128, (bf16*)(ws + WS_CW1K), 0, scr, r, F.lane); continue; } r -= I_C1;
        if (r < I_C1) { transpose_item<0>(F.in[18], 2048, 128, (bf16*)(ws + WS_CW1V), 0, scr, r, F.lane); continue; } r -= I_C1;
        if (r < I_C2) { transpose_item<0>(F.in[16], 128, 64, (bf16*)(ws + WS_CW2K), 0, scr, r, F.lane); continue; } r -= I_C2;
        if (r < I_C2) { transpose_item<0>(F.in[19], 128, 64, (bf16*)(ws + WS_CW2V), 0, scr, r, F.lane); continue; } r -= I_C2;
        if (r < I_LR) { const int h = r >> 1; transpose_item<0>(F.in[9] + h * 4096, 64, 64, (bf16*)(ws + WS_WAT), h * 64, scr, r & 1, F.lane); continue; } r -= I_LR;
        { const int h = r >> 1; transpose_item<0>(F.in[11] + h * 4096, 64, 64, (bf16*)(ws + WS_WXT), h * 64, scr, r & 1, F.lane); }
    }
    {
        const int gt = F.bid * NTHR + F.tid, NGT = F.G * NTHR;
        u32x4* z0 = (u32x4*)(ws + WS_WIN0 + (size_t)IN0 * 1024 * 2); const int n0 = (IN0P - IN0) * 1024 * 2 / 16;
        for (int i = gt; i < n0; i += NGT) z0[i] = (u32x4){0u, 0u, 0u, 0u};
        u32x4* z1 = (u32x4*)(ws + WS_WIN1 + (size_t)IN1 * 1024 * 2); const int n1 = (IN1P - IN1) * 1024 * 2 / 16;
        for (int i = gt; i < n1; i += NGT) z1[i] = (u32x4){0u, 0u, 0u, 0u};
    }
}

DI void norm_mod_phase(Frame& F, const float* X, const float* g, const float* shift, const float* scale, bf16* XN) {
    const int gw = F.bid * NWV + F.wave, NGW = F.G * NWV;
    for (int m = gw; m < MROWS; m += NGW) {
        const int b = m >> 11;
        const f32x4* xr = (const f32x4*)(X + (size_t)m * DM) + F.lane;
        f32x4 v[4]; float s = 0.f;
#pragma unroll
        for (int j = 0; j < 4; ++j) { v[j] = xr[64 * j]; s += (v[j].x * v[j].x + v[j].y * v[j].y) + (v[j].z * v[j].z + v[j].w * v[j].w); }
        const float rstd = 1.0f / sqrtf(wave_sum(s) * (1.f / DM) + 1e-6f);
        u32x2* o8 = (u32x2*)(XN + (size_t)m * DM) + F.lane;
#pragma unroll
        for (int j = 0; j < 4; ++j) {
            const f32x4 gg = ((const f32x4*)g)[F.lane + 64 * j];
            const f32x4 sc = ((const f32x4*)(scale + (size_t)b * 6144))[F.lane + 64 * j];
            const f32x4 sh = ((const f32x4*)(shift + (size_t)b * 6144))[F.lane + 64 * j];
            f32x4 y;
#pragma unroll
            for (int e = 0; e < 4; ++e) y[e] = v[j][e] * rstd * gg[e] * (1.0f + sc[e]) + sh[e];
            u32x2 w; w.x = pk2(y[0], y[1]); w.y = pk2(y[2], y[3]); o8[64 * j] = w;
        }
    }
}
DI void final_norm_phase(Frame& F, float* X, const float* g) {
    const int gw = F.bid * NWV + F.wave, NGW = F.G * NWV;
    for (int m = gw; m < MROWS; m += NGW) {
        f32x4* xr = (f32x4*)(X + (size_t)m * DM) + F.lane;
        f32x4 v[4]; float s = 0.f;
#pragma unroll
        for (int j = 0; j < 4; ++j) { v[j] = xr[64 * j]; s += (v[j].x * v[j].x + v[j].y * v[j].y) + (v[j].z * v[j].z + v[j].w * v[j].w); }
        const float rstd = 1.0f / sqrtf(wave_sum(s) * (1.f / DM) + 1e-6f);
#pragma unroll
        for (int j = 0; j < 4; ++j) { const f32x4 gg = ((const f32x4*)g)[F.lane + 64 * j]; xr[64 * j] = v[j] * rstd * gg; }
    }
}

DI void lru_stage1_item(Frame& F, int item) {
    const int b = item >> 7, h = (item >> 4) & 7, ck = item & 15, t0 = ck * 128;
    const int tid = opaque(F.tid), lane = tid & 63, w = F.wave, r32 = lane & 31, hi = lane >> 5;
    LAS bf16* XCB = (LAS bf16*)F.lds;
    LAS float* XCF = (LAS float*)(F.lds + 18432);
    LAS float* AL = (LAS float*)(F.lds + 18432 + 32768);
    LAS float* UL = (LAS float*)(F.lds + 18432 + 65536);
    LAS float* TOT = (LAS float*)(F.lds + 18432 + 98304);
    const bf16* P1 = (const bf16*)(F.ws + WS_BIG);
    {
        const int c = tid & 63, tg = tid >> 6, ch = h * 64 + c;
        const float* cw = F.in[7]; const float w0 = cw[ch], w1 = cw[512 + ch], w2 = cw[1024 + ch], w3 = cw[1536 + ch], cb = F.in[8][ch];
        const bf16* ax = P1 + (size_t)(b * SEQ) * IN0P + C_AX + ch;
        const int tt0 = t0 + tg * 16;
        float x3 = (tt0 - 3 >= 0) ? bf2f(ax[(size_t)(tt0 - 3) * IN0P]) : 0.f;
        float x2 = (tt0 - 2 >= 0) ? bf2f(ax[(size_t)(tt0 - 2) * IN0P]) : 0.f;
        float x1 = (tt0 - 1 >= 0) ? bf2f(ax[(size_t)(tt0 - 1) * IN0P]) : 0.f;
#pragma unroll 4
        for (int i = 0; i < 16; ++i) {
            const float x0 = bf2f(ax[(size_t)(tt0 + i) * IN0P]);
            const float v = w0 * x3 + w1 * x2 + w2 * x1 + w3 * x0 + cb;
            XCF[(tg * 16 + i) * 64 + c] = v; XCB[(tg * 16 + i) * 72 + c] = f2bf(v);
            x3 = x2; x2 = x1; x1 = x0;
        }
    }
    __syncthreads();
    {
        const int tb = w >> 1, cb2 = w & 1;
        const bf16* WAT = (const bf16*)(F.ws + WS_WAT); const bf16* WXT = (const bf16*)(F.ws + WS_WXT);
        f32x16 accA, accX;
#pragma unroll
        for (int r = 0; r < 16; ++r) { accA[r] = 0.f; accX[r] = 0.f; }
#pragma unroll
        for (int ks = 0; ks < 4; ++ks) {
            const bf16x8 a = *(const LAS bf16x8*)(XCB + (tb * 32 + r32) * 72 + ks * 16 + hi * 8);
            const bf16x8 ba = *(const bf16x8*)(WAT + (size_t)(h * 64 + cb2 * 32 + r32) * 64 + ks * 16 + hi * 8);
            const bf16x8 bx = *(const bf16x8*)(WXT + (size_t)(h * 64 + cb2 * 32 + r32) * 64 + ks * 16 + hi * 8);
            accA = MFMA32(a, ba, accA); accX = MFMA32(a, bx, accX);
        }
        const int j = cb2 * 32 + r32, chj = h * 64 + j;
        const float ba_ = F.in[10][chj], bx_ = F.in[12][chj];
        const float sp = log1pf(__expf(-F.in[13][chj]));
#pragma unroll
        for (int r = 0; r < 16; ++r) {
            const int tok = tb * 32 + crow(r, hi);
            const float rg = sigmoidf_(accA[r] + ba_), ig = sigmoidf_(accX[r] + bx_);
            const float la = -8.0f * rg * sp;
            const float a = __expf(la);
            float mult = sqrtf(-expm1f(2.0f * la));
            if (t0 + tok == 0) mult = 1.0f;
            AL[tok * 64 + j] = a; UL[tok * 64 + j] = mult * ig * XCF[tok * 64 + j];
        }
    }
    __syncthreads();
    {
        const int c = tid & 63, tg = tid >> 6, ch = h * 64 + c;
        float P = 1.f, hh = 0.f;
#pragma unroll 4
        for (int i = 0; i < 16; ++i) { const int o = (tg * 16 + i) * 64 + c; const float a = AL[o], u = UL[o]; hh = a * hh + u; P *= a; UL[o] = hh; AL[o] = P; }
        TOT[(tg * 64 + c) * 2] = P; TOT[(tg * 64 + c) * 2 + 1] = hh;
        __syncthreads();
        float Pc = 1.f, hc = 0.f;
        for (int s = 0; s < tg; ++s) { const float p = TOT[(s * 64 + c) * 2], q = TOT[(s * 64 + c) * 2 + 1]; hc = p * hc + q; Pc *= p; }
        float* HL = (float*)(F.ws + WS_HL); float* PCm = (float*)(F.ws + WS_PC);
#pragma unroll 4
        for (int i = 0; i < 16; ++i) { const int o = (tg * 16 + i) * 64 + c; const size_t go = (size_t)(b * SEQ + t0 + tg * 16 + i) * 512 + ch;
            HL[go] = UL[o] + AL[o] * hc; PCm[go] = AL[o] * Pc; }
    }
    __syncthreads();
}
DI void lru_stage2_item(Frame& F, int item) {
    const int b = item >> 4, ck = item & 15, ch = opaque(F.tid);
    const float* HL = (const float*)(F.ws + WS_HL); const float* PCm = (const float*)(F.ws + WS_PC);
    const bf16* P1 = (const bf16*)(F.ws + WS_BIG); bf16* Y = (bf16*)(F.ws + WS_Y);
    float hc = 0.f;
    for (int j = 0; j < ck; ++j) { const size_t ro = (size_t)(b * SEQ + j * 128 + 127) * 512 + ch; hc = PCm[ro] * hc + HL[ro]; }
#pragma unroll 4
    for (int tok = 0; tok < 128; ++tok) {
        const size_t row = (size_t)(b * SEQ + ck * 128 + tok);
        const float hv = HL[row * 512 + ch] + PCm[row * 512 + ch] * hc;
        const float ag = bf2f(P1[row * IN0P + C_AGATE + ch]);
        Y[row * DM + ch] = f2bf(hv * gelu_tanh(ag));
    }
}

DI void cmp_item(Frame& F, int item) {
    const int kv = item >> 7, rest = item & 127, b = rest >> 3, g = (rest >> 2) & 1, cc = rest & 3;
    const int lane = opaque(F.lane), w = F.wave, r32 = lane & 31, hi = lane >> 5;
    const bf16* P1 = (const bf16*)(F.ws + WS_BIG);
    const bf16* W1T = (const bf16*)(F.ws + (kv ? WS_CW1V : WS_CW1K)); const bf16* W2T = (const bf16*)(F.ws + (kv ? WS_CW2V : WS_CW2K));
    const float* CB1 = (const float*)(F.ws + WS_CB1) + kv * 128;
    bf16* OUT = (bf16*)(F.ws + (kv ? WS_VC : WS_KC));
    LAS float* RED = (LAS float*)F.lds;
    LAS bf16* HD = (LAS bf16*)(F.lds + 16384);
    const int nb = w & 3, kh = w >> 2;
    const int c = cc * 32 + r32, cl = c < 126 ? c : 126;
    const bf16* arow = P1 + (size_t)(b * SEQ + 16 * cl) * IN0P + (kv ? C_VC : C_KC) + g * 64;
    const bf16* brow = W1T + (size_t)(nb * 32 + r32) * 2048;
    f32x16 acc;
#pragma unroll
    for (int r = 0; r < 16; ++r) acc[r] = 0.f;
#pragma unroll 8
    for (int s = 0; s < 64; ++s) {
        const int k = kh * 1024 + s * 16 + hi * 8, l = k >> 6, d = k & 63;
        const bf16x8 a = *(const bf16x8*)(arow + (size_t)l * IN0P + d);
        const bf16x8 bw = *(const bf16x8*)(brow + k);
        acc = MFMA32(a, bw, acc);
    }
    if (kh == 1) {
#pragma unroll
        for (int r = 0; r < 16; ++r) RED[(nb * 16 + r) * 64 + lane] = acc[r];
    }
    __syncthreads();
    if (kh == 0) {
        const int n = nb * 32 + r32; const float bias = CB1[n];
#pragma unroll
        for (int r = 0; r < 16; ++r) { const float v = acc[r] + RED[(nb * 16 + r) * 64 + lane] + bias; HD[crow(r, hi) * 136 + n] = f2bf(gelu_tanh(v)); }
    }
    __syncthreads();
    if (w < 2) {
        f32x16 a2;
#pragma unroll
        for (int r = 0; r < 16; ++r) a2[r] = 0.f;
#pragma unroll
        for (int ks = 0; ks < 8; ++ks) {
            const bf16x8 a = *(const LAS bf16x8*)(HD + r32 * 136 + ks * 16 + hi * 8);
            const bf16x8 bw = *(const bf16x8*)(W2T + (size_t)(w * 32 + r32) * 128 + ks * 16 + hi * 8);
            a2 = MFMA32(a, bw, a2);
        }
        const int d = w * 32 + r32;
#pragma unroll
        for (int r = 0; r < 16; ++r) { const int co = cc * 32 + crow(r, hi); OUT[((size_t)(b * 2 + g) * 128 + co) * 64 + d] = (co < 127) ? f2bf(a2[r]) : (bf16)0; }
    }
    __syncthreads();
}

constexpr int TP = 144;
struct AttnState { f32x16 o0, o1; float m, l; };
DI void attn_init(AttnState& st) {
#pragma unroll
    for (int r = 0; r < 16; ++r) { st.o0[r] = 0.f; st.o1[r] = 0.f; }
    st.m = -INFINITY; st.l = 0.f;
}
DI void load_tile(const bf16* g, size_t pitch, LAS unsigned char* dst, int tid) {
    const int key = tid >> 3, ch = tid & 7;
    const u32x4 v = *(const u32x4*)(g + (size_t)key * pitch + ch * 8);
    *(LAS u32x4*)(dst + key * TP + ch * 16) = v;
}
DI f32x16 qk_block(const LAS unsigned char* Kt, int kb, const bf16x8 (&qf)[4], int r32, int hi) {
    f32x16 s;
#pragma unroll
    for (int r = 0; r < 16; ++r) s[r] = 0.f;
#pragma unroll
    for (int ks = 0; ks < 4; ++ks) {
        const bf16x8 kf = *(const LAS bf16x8*)(Kt + (kb * 32 + r32) * TP + (ks * 16 + hi * 8) * 2);
        s = MFMA32(kf, qf[ks], s);
    }
    return s;
}
DI void pv_block(const LAS unsigned char* Vt, int kb, const f32x16& p, f32x16& o0, f32x16& o1, int lane) {
    const int hi = lane >> 5, i16 = lane & 15, q = i16 >> 2, pp = i16 & 3, blk = (lane >> 4) & 1;
#pragma unroll
    for (int s2 = 0; s2 < 2; ++s2) {
        u32x4 pw; pw.x = pk2(p[8 * s2 + 0], p[8 * s2 + 1]); pw.y = pk2(p[8 * s2 + 2], p[8 * s2 + 3]); pw.z = pk2(p[8 * s2 + 4], p[8 * s2 + 5]); pw.w = pk2(p[8 * s2 + 6], p[8 * s2 + 7]);
        const bf16x8 pf = __builtin_bit_cast(bf16x8, pw);
        const int rlo = kb * 32 + 16 * s2 + 4 * hi + q, rhi = rlo + 8;
#pragma unroll
        for (int db = 0; db < 2; ++db) {
            const int cbyte = (32 * db + 16 * blk + 4 * pp) * 2;
            const s16x4 lo = vtr((const LAS char*)(Vt + rlo * TP + cbyte));
            const s16x4 hv = vtr((const LAS char*)(Vt + rhi * TP + cbyte));
            const bf16x8 vf = (bf16x8){lo[0], lo[1], lo[2], lo[3], hv[0], hv[1], hv[2], hv[3]};
            if (db == 0) o0 = MFMA32(vf, pf, o0); else o1 = MFMA32(vf, pf, o1);
        }
    }
}
template <class MaskF>
DI void attn_tile(const LAS unsigned char* Kt, const LAS unsigned char* Vt, const bf16x8 (&qf)[4], AttnState& st, float sl2, MaskF mask, int lane) {
    const int r32 = lane & 31, hi = lane >> 5;
    f32x16 s[2];
    float mx = -INFINITY;
#pragma unroll
    for (int kb = 0; kb < 2; ++kb) {
        s[kb] = qk_block(Kt, kb, qf, r32, hi);
#pragma unroll
        for (int r = 0; r < 16; ++r) { float v = s[kb][r] * sl2; if (!mask(kb * 32 + crow(r, hi))) v = -INFINITY; s[kb][r] = v; mx = fmaxf(mx, v); }
    }
    mx = fmaxf(mx, __shfl_xor(mx, 32));
    const float mn = fmaxf(st.m, mx), mu = (mn == -INFINITY) ? 0.f : mn;
    const float alpha = __builtin_amdgcn_exp2f(st.m - mu);
    float ls = 0.f;
#pragma unroll
    for (int kb = 0; kb < 2; ++kb)
#pragma unroll
        for (int r = 0; r < 16; ++r) { const float p = __builtin_amdgcn_exp2f(s[kb][r] - mu); s[kb][r] = p; ls += p; }
    st.l = st.l * alpha + ls; st.m = mn;
#pragma unroll
    for (int r = 0; r < 16; ++r) { st.o0[r] *= alpha; st.o1[r] *= alpha; }
    pv_block(Vt, 0, s[0], st.o0, st.o1, lane);
    pv_block(Vt, 1, s[1], st.o0, st.o1, lane);
}
DI void attn_fold(const AttnState& st, float gate, f32x16& f0, f32x16& f1) {
    const float lt = st.l + __shfl_xor(st.l, 32);
    const float sc = lt > 0.f ? gate / lt : 0.f;
#pragma unroll
    for (int r = 0; r < 16; ++r) { f0[r] += sc * st.o0[r]; f1[r] += sc * st.o1[r]; }
}
DI void store_rowT(bf16* dst, const f32x16& f0, const f32x16& f1, int hi) {
#pragma unroll
    for (int rr = 0; rr < 4; ++rr) {
        u32x2 w0; w0.x = pk2(f0[4 * rr], f0[4 * rr + 1]); w0.y = pk2(f0[4 * rr + 2], f0[4 * rr + 3]);
        u32x2 w1; w1.x = pk2(f1[4 * rr], f1[4 * rr + 1]); w1.y = pk2(f1[4 * rr + 2], f1[4 * rr + 3]);
        *(u32x2*)(dst + 8 * rr + 4 * hi) = w0; *(u32x2*)(dst + 32 + 8 * rr + 4 * hi) = w1;
    }
}

DI void nsa_item(Frame& F, int it) {
    const int bg = it & 31, u = it >> 5, rq = u >> 3, sq = u & 7;
    const int qb = rq == 0 ? sq : rq == 1 ? 15 - sq : rq == 2 ? 16 + sq : 31 - sq;
    const int b = bg >> 1, g = bg & 1;
    const int tid = opaque(F.tid), lane = tid & 63, w = F.wave, r32 = lane & 31, hi = lane >> 5;
    LAS unsigned char* KT0 = F.lds; LAS unsigned char* KT1 = F.lds + 9216; LAS unsigned char* VT0 = F.lds + 18432; LAS unsigned char* VT1 = F.lds + 27648;
    LAS float* PS = (LAS float*)(F.lds + 36864) + w * 1024;
    LAS unsigned* SELM = (LAS unsigned*)(F.lds + 36864 + 32768);
    const bf16* P1 = (const bf16*)(F.ws + WS_BIG);
    const int t = qb * 64 + w * 8 + (r32 >> 2), hd = r32 & 3, head = g * 4 + hd;
    const bf16* rowp = P1 + (size_t)(b * SEQ + t) * IN0P;
    bf16x8 qf[4];
#pragma unroll
    for (int ks = 0; ks < 4; ++ks) qf[ks] = *(const bf16x8*)(rowp + C_Q + head * 64 + ks * 16 + hi * 8);
    const float g0 = sigmoidf_(bf2f(rowp[C_GT + head * 3 + 0])), g1 = sigmoidf_(bf2f(rowp[C_GT + head * 3 + 1])), g2 = sigmoidf_(bf2f(rowp[C_GT + head * 3 + 2]));
    const float sl2 = 0.125f * 1.4426950408889634f;
    f32x16 f0, f1;
#pragma unroll
    for (int r = 0; r < 16; ++r) { f0[r] = 0.f; f1[r] = 0.f; }
    {
        const int ntc = (qb <= 15) ? 1 : 2;
        const bf16* KC = (const bf16*)(F.ws + WS_KC) + (size_t)bg * 128 * 64; const bf16* VC = (const bf16*)(F.ws + WS_VC) + (size_t)bg * 128 * 64;
        __syncthreads();
        load_tile(KC, 64, KT0, tid); load_tile(VC, 64, VT0, tid);
        if (ntc == 2) { load_tile(KC + 64 * 64, 64, KT1, tid); load_tile(VC + 64 * 64, 64, VT1, tid); }
        __syncthreads();
        f32x16 sc[4];
        float mx = -INFINITY;
#pragma unroll
        for (int blk = 0; blk < 4; ++blk) {
            if ((blk >> 1) < ntc) {
                sc[blk] = qk_block((blk >> 1) ? KT1 : KT0, blk & 1, qf, r32, hi);
#pragma unroll
                for (int r = 0; r < 16; ++r) { const int c = blk * 32 + crow(r, hi); float v = sc[blk][r] * sl2; if (16 * c + 31 > t) v = -INFINITY; sc[blk][r] = v; mx = fmaxf(mx, v); }
            } else {
#pragma unroll
                for (int r = 0; r < 16; ++r) sc[blk][r] = -INFINITY;
            }
        }
        mx = fmaxf(mx, __shfl_xor(mx, 32));
        const float mu = (mx == -INFINITY) ? 0.f : mx;
        float ls = 0.f;
#pragma unroll
        for (int blk = 0; blk < 4; ++blk)
#pragma unroll
            for (int r = 0; r < 16; ++r) { const float p = __builtin_amdgcn_exp2f(sc[blk][r] - mu); sc[blk][r] = p; ls += p; }
        ls += __shfl_xor(ls, 32);
        const float inv = ls > 0.f ? 1.0f / ls : 0.f;
#pragma unroll
        for (int blk = 0; blk < 4; ++blk)
#pragma unroll
            for (int r = 0; r < 16; ++r) sc[blk][r] *= inv;
        pv_block(VT0, 0, sc[0], f0, f1, lane); pv_block(VT0, 1, sc[1], f0, f1, lane);
        if (ntc == 2) { pv_block(VT1, 0, sc[2], f0, f1, lane); pv_block(VT1, 1, sc[3], f0, f1, lane); }
#pragma unroll
        for (int r = 0; r < 16; ++r) { f0[r] *= g0; f1[r] *= g0; }
#pragma unroll
        for (int blk = 0; blk < 4; ++blk)
#pragma unroll
            for (int r = 0; r < 16; ++r) { float v = sc[blk][r]; v += __shfl_xor(v, 1); v += __shfl_xor(v, 2); if (hd == 0) PS[(r32 >> 2) * 128 + blk * 32 + crow(r, hi)] = v; }
        __syncthreads();
        {
            const int tok8 = lane >> 3, jq = lane & 7;
            float imp[4];
#pragma unroll
            for (int e = 0; e < 4; ++e) {
                const int j = 4 * jq + e; float v = 0.f;
#pragma unroll
                for (int dc = -1; dc <= 3; ++dc) { const int c = 4 * j + dc; if (c >= 0) v += PS[tok8 * 128 + c]; }
                if (j == 0 || j == qb || j == qb - 1) v = 1e4f;
                if (j > qb) v = -INFINITY;
                imp[e] = v;
            }
            unsigned sel = 0u;
            for (int itr = 0; itr < 8; ++itr) {
                float bv = imp[0]; int bj = 4 * jq;
#pragma unroll
                for (int e = 1; e < 4; ++e) if (imp[e] > bv) { bv = imp[e]; bj = 4 * jq + e; }
#pragma unroll
                for (int o = 1; o < 8; o <<= 1) { const float ov = __shfl_xor(bv, o); const int oj = __shfl_xor(bj, o); if (ov > bv || (ov == bv && oj < bj)) { bv = ov; bj = oj; } }
                sel |= 1u << bj;
#pragma unroll
                for (int e = 0; e < 4; ++e) if (4 * jq + e == bj) imp[e] = -INFINITY;
            }
            if (jq == 0) SELM[w * 8 + tok8] = sel;
        }
        __syncthreads();
    }
    const unsigned mysel = SELM[w * 8 + (r32 >> 2)];
    {
        AttnState st; attn_init(st);
        for (int j = 0; j <= qb; ++j) {
            __syncthreads();
            const bf16* kp = P1 + (size_t)(b * SEQ + j * 64) * IN0P + C_KS + g * 64;
            load_tile(kp, IN0P, KT0, tid); load_tile(kp + (C_VS - C_KS), IN0P, VT0, tid);
            __syncthreads();
            const bool rs = (mysel >> j) & 1u;
            if (__any(rs)) attn_tile(KT0, VT0, qf, st, sl2, [&](int kk) { return rs && (j * 64 + kk <= t); }, lane);
        }
        attn_fold(st, g1, f0, f1);
    }
    {
        AttnState st; attn_init(st);
        for (int j = (qb >= 8 ? qb - 8 : 0); j <= qb; ++j) {
            __syncthreads();
            const bf16* kp = P1 + (size_t)(b * SEQ + j * 64) * IN0P + C_KW + g * 64;
            load_tile(kp, IN0P, KT0, tid); load_tile(kp + (C_VW - C_KW), IN0P, VT0, tid);
            __syncthreads();
            attn_tile(KT0, VT0, qf, st, sl2, [&](int kk) { const int kpz = j * 64 + kk; return kpz <= t && kpz > t - 512; }, lane);
        }
        attn_fold(st, g2, f0, f1);
    }
    bf16* Y = (bf16*)(F.ws + WS_Y);
    store_rowT(Y + (size_t)(b * SEQ + t) * DM + 512 + head * 64, f0, f1, hi);
}

DI unsigned f2key(float f) { unsigned u = __float_as_uint(f); if (u == 0x80000000u) u = 0u; return (u & 0x80000000u) ? ~u : (u | 0x80000000u); }
DI int half_sum(int v) {
#pragma unroll
    for (int o = 1; o < 32; o <<= 1) v += __shfl_xor(v, o);
    return v;
}
DI void dsa_index_item(Frame& F, int it) {
    const int b = it >> 6, qt = it & 63;
    const int lane = opaque(F.lane), w = F.wave, r32 = lane & 31, hi = lane >> 5;
    const bf16* L1 = (const bf16*)(F.ws + WS_BIG);
    unsigned* MASK = (unsigned*)(F.ws + WS_MASK) + (size_t)(b * 64 + qt) * 64 * 32;
    LAS unsigned* KEYS = (LAS unsigned*)F.lds + (w * 2 + hi) * 2048;
    const int tq0 = qt * 32 + w * 4;
    bf16x8 af[4];
    {
        const int qi = r32 >> 3, h = r32 & 7;
        const bf16* qp = L1 + (size_t)(b * SEQ + tq0 + qi) * IN1P + D_QI + h * 64;
#pragma unroll
        for (int ks = 0; ks < 4; ++ks) af[ks] = *(const bf16x8*)(qp + ks * 16 + hi * 8);
    }
    const int kbmax = qt;
    const bf16* kbase = L1 + (size_t)(b * SEQ + r32) * IN1P + D_KI + hi * 8;
#pragma unroll 1
    for (int pass = 0; pass < 2; ++pass) {
        const bool p1 = pass != 0;
        const int tqq = tq0 + 2 * hi + pass;
        const int qin = w * 4 + 2 * hi + pass;
        float wA[4], wB[4];
#pragma unroll
        for (int e = 0; e < 4; ++e) {
            wA[e] = bf2f(L1[(size_t)(b * SEQ + tq0 + pass) * IN1P + D_WI + e + 4 * hi]) * (0.125f * 0.35355339059327373f);
            wB[e] = bf2f(L1[(size_t)(b * SEQ + tq0 + 2 + pass) * IN1P + D_WI + e + 4 * hi]) * (0.125f * 0.35355339059327373f);
        }
        __syncthreads();
        for (int kb = kbmax + 1; kb < 64; ++kb) KEYS[kb * 32 + r32] = 0x007fffffu;
#pragma unroll 2
        for (int kb = 0; kb <= kbmax; ++kb) {
            f32x16 acc;
#pragma unroll
            for (int r = 0; r < 16; ++r) acc[r] = 0.f;
            const bf16* kp = kbase + (size_t)(kb * 32) * IN1P;
#pragma unroll
            for (int ks = 0; ks < 4; ++ks) { const bf16x8 bfr = *(const bf16x8*)(kp + ks * 16); acc = MFMA32(af[ks], bfr, acc); }
            float sA = 0.f, sB = 0.f;
#pragma unroll
            for (int e = 0; e < 4; ++e) { sA += wA[e] * fmaxf(p1 ? acc[4 + e] : acc[e], 0.f); sB += wB[e] * fmaxf(p1 ? acc[12 + e] : acc[8 + e], 0.f); }
            const float own = hi ? sB : sA, forp = hi ? sA : sB;
            const float sc = own + __shfl_xor(forp, 32);
            KEYS[kb * 32 + r32] = f2key((kb * 32 + r32 <= tqq) ? sc : -INFINITY);
        }
        __syncthreads();
        unsigned kk[64];
#pragma unroll
        for (int kb = 0; kb < 64; ++kb) kk[kb] = KEYS[kb * 32 + r32];
        const bool full = tqq < 256;
        unsigned tau = 0u;
        for (int bit = 31; bit >= 0; --bit) {
            const unsigned cand = tau | (1u << bit);
            int cnt = 0;
#pragma unroll
            for (int kb = 0; kb < 64; ++kb) cnt += (kk[kb] >= cand) ? 1 : 0;
            cnt = half_sum(cnt);
            if (cnt >= 256) tau = cand;
        }
        int need;
        {
            int cgt = 0;
#pragma unroll
            for (int kb = 0; kb < 64; ++kb) cgt += (kk[kb] > tau) ? 1 : 0;
            cgt = half_sum(cgt);
            need = 256 - cgt;
        }
        int running = 0;
#pragma unroll
        for (int kb = 0; kb < 64; ++kb) {
            const bool tie = (kk[kb] == tau);
            const unsigned long long bal = __ballot(tie);
            const unsigned hb = hi ? (unsigned)(bal >> 32) : (unsigned)bal;
            const int before = running + __popc(hb & ((1u << r32) - 1u));
            running += __popc(hb);
            bool sel = (kk[kb] > tau) || (tie && before < need);
            if (full) sel = (kb * 32 + r32) <= tqq;
            const unsigned long long sb = __ballot(sel);
            const unsigned word = hi ? (unsigned)(sb >> 32) : (unsigned)sb;
            if (r32 == 0) MASK[(size_t)kb * 32 + qin] = word;
        }
    }
}

DI void dsa_attn_item(Frame& F, int it) {
    const int bg = it & 31, u = it >> 5, rq = u >> 3, sq = u & 7;
    const int qt = (rq >> 1) * 16 + ((rq & 1) ? 15 - sq : sq);
    const int b = bg >> 1, g = bg & 1;
    const int tid = opaque(F.tid), lane = tid & 63, w = F.wave, r32 = lane & 31, hi = lane >> 5;
    LAS unsigned char* KT0 = F.lds; LAS unsigned char* VT0 = F.lds + 9216;
    const bf16* L1 = (const bf16*)(F.ws + WS_BIG);
    const unsigned* MASK = (const unsigned*)(F.ws + WS_MASK) + (size_t)(b * 64 + qt) * 64 * 32;
    const int t = qt * 32 + r32, head = g * 8 + w;
    const bf16* rowp = L1 + (size_t)(b * SEQ + t) * IN1P;
    bf16x8 qf[4];
#pragma unroll
    for (int ks = 0; ks < 4; ++ks) qf[ks] = *(const bf16x8*)(rowp + D_Q + head * 64 + ks * 16 + hi * 8);
    const float sl2 = 0.125f * 1.4426950408889634f;
    AttnState st; attn_init(st);
    const int nt = (qt >> 1) + 1;
    for (int j = 0; j < nt; ++j) {
        __syncthreads();
        const bf16* kp = L1 + (size_t)(b * SEQ + j * 64) * IN1P + D_K + g * 64;
        load_tile(kp, IN1P, KT0, tid); load_tile(kp + (D_V - D_K), IN1P, VT0, tid);
        const unsigned mw0 = MASK[(size_t)(2 * j) * 32 + r32], mw1 = MASK[(size_t)(2 * j + 1) * 32 + r32];
        __syncthreads();
        attn_tile(KT0, VT0, qf, st, sl2, [&](int kk) { return (((kk & 32) ? mw1 : mw0) >> (kk & 31)) & 1u; }, lane);
    }
    f32x16 f0, f1;
#pragma unroll
    for (int r = 0; r < 16; ++r) { f0[r] = 0.f; f1[r] = 0.f; }
    attn_fold(st, 1.0f, f0, f1);
    bf16* Y = (bf16*)(F.ws + WS_Y);
    store_rowT(Y + (size_t)(b * SEQ + t) * DM + head * 64, f0, f1, hi);
}

__global__ void __launch_bounds__(NTHR) fwd_megakernel(Args args) {
    extern __shared__ __attribute__((aligned(16))) unsigned char lds_raw[];
    cg::grid_group grid = cg::this_grid();
    Frame F;
    F.lds = (LAS unsigned char*)lds_raw;
    F.tid = threadIdx.x; F.lane = F.tid & 63; F.wave = __builtin_amdgcn_readfirstlane(F.tid >> 6);
    F.G = gridDim.x; F.bid = blockIdx.x;
    F.in = args.in; F.out = args.out; F.ws = args.ws;
    unsigned char* ws = args.ws;
    const float* MOD0 = (const float*)(ws + WS_MOD0); const float* MOD1 = (const float*)(ws + WS_MOD1);
    bf16* XN = (bf16*)(ws + WS_XN); bf16* BIG = (bf16*)(ws + WS_BIG); bf16* Y = (bf16*)(ws + WS_Y);
    typedef pg8::StaticOrder SO;
#define GRID_SYNC() grid.sync()

#ifndef PHMASK
#define PHMASK 0xffffffu
#endif
#define PH(n) if (PHMASK & (1u << (n)))
    PH(0) p0_prologue(F);
    GRID_SYNC();
    PH(1) norm_mod_phase(F, F.in[0], F.in[2], MOD0 + 0, MOD0 + 1024, XN);
    GRID_SYNC();
    PH(2) { pg8::Gemm g{XN, (const bf16*)(ws + WS_WIN0), MROWS, IN0P, DM}; SO S; S.init(MROWS, IN0P, F.G, F.bid); pg8::EpiStoreBf16 E{BIG, IN0P};
      pg8::gemm_phase<pg8::EpiStoreBf16, SO, true, true>(F.lds, g, S, E); }
    GRID_SYNC();
    for (int it = F.bid; it < 2048 + 256; it += F.G) { if (it < 2048) { PH(3) lru_stage1_item(F, it); } else { PH(4) cmp_item(F, it - 2048); } }
    GRID_SYNC();
    for (int it = F.bid; it < 1024 + 256; it += F.G) { if (it < 1024) { PH(5) nsa_item(F, it); } else { PH(6) lru_stage2_item(F, it - 1024); } }
    GRID_SYNC();
    PH(7) { pg8::Gemm g{Y, (const bf16*)(ws + WS_WOUT0), MROWS, DM, DM}; SO S; S.init(MROWS, DM, F.G, F.bid); pg8::EpiResGate E{F.in[0], F.out, MOD0 + 2048, 6144};
      pg8::gemm_phase<pg8::EpiResGate, SO, true, true>(F.lds, g, S, E); }
    GRID_SYNC();
    PH(8) norm_mod_phase(F, F.out, F.in[3], MOD0 + 3072, MOD0 + 4096, XN);
    GRID_SYNC();
    PH(9) { pg8::Gemm g{XN, (const bf16*)(ws + WS_WGU0), MROWS, 2 * DFF, DM}; SO S; S.init(MROWS, 2 * DFF, F.G, F.bid); pg8::EpiSwiGLU E{BIG, DFF};
      pg8::gemm_phase<pg8::EpiSwiGLU, SO, true, true>(F.lds, g, S, E); }
    GRID_SYNC();
    PH(10) { pg8::Gemm g{BIG, (const bf16*)(ws + WS_WD0), MROWS, DM, DFF}; SO S; S.init(MROWS, DM, F.G, F.bid); pg8::EpiResGate E{F.out, F.out, MOD0 + 5120, 6144};
      pg8::gemm_phase<pg8::EpiResGate, SO, true, true>(F.lds, g, S, E); }
    GRID_SYNC();
    PH(11) norm_mod_phase(F, F.out, F.in[24], MOD1 + 0, MOD1 + 1024, XN);
    GRID_SYNC();
    PH(12) { pg8::Gemm g{XN, (const bf16*)(ws + WS_WIN1), MROWS, IN1P, DM}; SO S; S.init(MROWS, IN1P, F.G, F.bid); pg8::EpiStoreBf16 E{BIG, IN1P};
      pg8::gemm_phase<pg8::EpiStoreBf16, SO, true, true>(F.lds, g, S, E); }
    GRID_SYNC();
    PH(13) for (int it = F.bid; it < 1024; it += F.G) dsa_index_item(F, it);
    GRID_SYNC();
    PH(14) for (int it = F.bid; it < 2048; it += F.G) dsa_attn_item(F, it);
    GRID_SYNC();
    PH(15) { pg8::Gemm g{Y, (const bf16*)(ws + WS_WOUT1), MROWS, DM, DM}; SO S; S.init(MROWS, DM, F.G, F.bid); pg8::EpiResGate E{F.out, F.out, MOD1 + 2048, 6144};
      pg8::gemm_phase<pg8::EpiResGate, SO, true, true>(F.lds, g, S, E); }
    GRID_SYNC();
    PH(16) norm_mod_phase(F, F.out, F.in[25], MOD1 + 3072, MOD1 + 4096, XN);
    GRID_SYNC();
    PH(17) { pg8::Gemm g{XN, (const bf16*)(ws + WS_WGU1), MROWS, 2 * DFF, DM}; SO S; S.init(MROWS, 2 * DFF, F.G, F.bid); pg8::EpiSwiGLU E{BIG, DFF};
      pg8::gemm_phase<pg8::EpiSwiGLU, SO, true, true>(F.lds, g, S, E); }
    GRID_SYNC();
    PH(18) { pg8::Gemm g{BIG, (const bf16*)(ws + WS_WD1), MROWS, DM, DFF}; SO S; S.init(MROWS, DM, F.G, F.bid); pg8::EpiResGate E{F.out, F.out, MOD1 + 5120, 6144};
      pg8::gemm_phase<pg8::EpiResGate, SO, true, true>(F.lds, g, S, E); }
    GRID_SYNC();
    PH(19) final_norm_phase(F, F.out, F.in[33]);
}

extern "C" void kernel_launch(void* const* d_in, const int* in_sizes, int n_in, void* d_out, int out_size, void* d_ws, size_t ws_size, hipStream_t stream) {
    static int grid = 0;
    if (grid == 0) {
        if (n_in != 34 || in_sizes[0] != MROWS * DM || out_size != MROWS * DM || ws_size < WS_END) {
            fprintf(stderr, "kernel_launch: unexpected shapes (n_in %d, in0 %d, out %d, ws %zu); nothing launched\n", n_in, n_in > 0 ? in_sizes[0] : -1, out_size, ws_size); grid = -1; return; }
        int dev = 0, cus = 0, per_cu = 0;
        if (hipGetDevice(&dev) != hipSuccess || hipDeviceGetAttribute(&cus, hipDeviceAttributeMultiprocessorCount, dev) != hipSuccess) { grid = -1; return; }
        if (hipFuncSetAttribute((const void*)fwd_megakernel, hipFuncAttributeMaxDynamicSharedMemorySize, LDS_BYTES) != hipSuccess) { fprintf(stderr, "kernel_launch: hipFuncSetAttribute failed\n"); grid = -1; return; }
        if (hipOccupancyMaxActiveBlocksPerMultiprocessor(&per_cu, (const void*)fwd_megakernel, NTHR, LDS_BYTES) != hipSuccess || per_cu < 1) { fprintf(stderr, "kernel_launch: occupancy query says %d\n", per_cu); grid = -1; return; }
        grid = cus;
    }
    if (grid < 0) return;
    Args a{};
    for (int i = 0; i < 34; ++i) a.in[i] = (const float*)d_in[i];
    a.out = (float*)d_out; a.ws = (unsigned char*)d_ws;
    void* kargs[] = {&a};
    hipError_t e = hipLaunchCooperativeKernel((const void*)fwd_megakernel, dim3(grid), dim3(NTHR), kargs, LDS_BYTES, stream);
    if (e != hipSuccess) fprintf(stderr, "kernel_launch: cooperative launch failed: %s (grid %d)\n", hipGetErrorString(e), grid);
}
```

```cpp
#include <hip/hip_runtime.h>
#include <cstdio>
#include <cstdint>
namespace pg8 {
#define PG8_LAS __attribute__((address_space(3)))
typedef unsigned short bf16_t;
typedef short bf16x8 __attribute__((ext_vector_type(8)));
typedef float f32x4 __attribute__((ext_vector_type(4)));
typedef unsigned u32x4 __attribute__((ext_vector_type(4)));
constexpr int BM = 256, BK = 64, HALF = 128, HTB = HALF * BK * 2  , STAGE_BYTES = 8 * HTB, NXCD = 8, WGM = 4;

__host__ __device__ __forceinline__ int lds_byte(int r, int c) { const int st = (r >> 4) * 2 + (c >> 5), rr = r & 15, cc = c & 31, ob = rr * 64 + cc * 2; return st * 1024 + (ob ^ (((ob >> 9) & 1) << 5)); }
__host__ __device__ __forceinline__ void stage_rc(int b, int& R, int& C) { const int st = b / 1024, sb = b % 1024, swz = sb ^ (((sb >> 9) & 1) << 5); R = (st >> 1) * 16 + swz / 64; C = (st & 1) * 32 + (swz % 64) / 2; }
__host__ __device__ __forceinline__ int perm32(int rho) { const int n = rho >> 4, i = rho & 15; return 8 * (i >> 2) + 4 * n + (i & 3); }

#ifdef REP_K
struct Unit { int pm, pn, skip; };
#else
struct Unit { int pm, pn; };
#endif
struct Gemm { const bf16_t* A; const bf16_t* Bt; int M, N, K; void* dummy; };

struct StaticOrder {
    int nM, nN, nwg, G, c;
    __host__ __device__ void init(int M, int N, int G_, int c_) { nM = M / BM; nN = N / BM; nwg = nM * nN; G = G_; c = c_; }
    __host__ __device__ bool next(int i, Unit& u) const {
        const long L = (long)i * G + c; if (L >= nwg) return false;
        int wgid = (int)L; { const int q = nwg / NXCD, r = nwg % NXCD, xcd = wgid % NXCD, off = wgid / NXCD; wgid = (xcd < r ? xcd * (q + 1) : r * (q + 1) + (xcd - r) * q) + off; }
        const int nig = WGM * nN, gid = wgid / nig, fm = gid * WGM, gsz = (nM - fm) < WGM ? (nM - fm) : WGM;
        u.pm = fm + ((wgid % nig) % gsz); u.pn = (wgid % nig) / gsz;
#ifdef REP_K
        u.skip = 0;
#endif
        return true;
    }
    __device__ __forceinline__ void a_ready(const Unit&) const {}
    __device__ __forceinline__ void done(const Unit&) const {}
};
#ifdef REP_K
struct DoubleOrder {
    StaticOrder in;
    __host__ __device__ void init(int M, int N, int G_, int c_) { in.init(M, N, G_, c_); }
    __host__ __device__ bool next(int i, Unit& u) const { const bool ok = in.next(i >> 1, u); u.skip = !(i & 1); return ok; }
    __device__ __forceinline__ void a_ready(const Unit&) const {}
    __device__ __forceinline__ void done(const Unit&) const {}
};
#endif

typedef float f32x2v __attribute__((ext_vector_type(2)));
typedef __bf16 bf16x2v __attribute__((ext_vector_type(2)));
typedef unsigned u32x2 __attribute__((ext_vector_type(2)));
__device__ __forceinline__ unsigned cvt_pk_bf16(float lo, float hi) { f32x2v v = {lo, hi}; bf16x2v b = __builtin_convertvector(v, bf16x2v); return __builtin_bit_cast(unsigned, b); }

struct EpiStoreBf16 {
    static constexpr bool PERM = true, AFTER_DRAIN = false, IDEMP = true, HAS_DUMMY = true, PERM64 = true;
    bf16_t* O; int ldc;
    __device__ __forceinline__ void operator()(const f32x4 (&acc)[2][2][4][2], const Unit& u, int wr, int wc, int fr, int fq) const {
        const int row0 = u.pm * BM + wr * 64 + (fr & 7), col0 = u.pn * BM + wc * 64 + 8 * ((fr >> 3) * 4 + fq);
#pragma unroll
        for (int ai = 0; ai < 2; ++ai)
#pragma unroll
            for (int m = 0; m < 4; ++m) { bf16_t* rowp = O + (size_t)(row0 + ai * HALF + m * 16) * ldc + col0;
                u32x4 w[2];
#pragma unroll
                for (int bj = 0; bj < 2; ++bj) { const f32x4 v0 = acc[ai][bj][m][0], v1 = acc[ai][bj][m][1];
                    w[bj].x = cvt_pk_bf16(v0[0], v0[1]); w[bj].y = cvt_pk_bf16(v0[2], v0[3]); w[bj].z = cvt_pk_bf16(v1[0], v1[1]); w[bj].w = cvt_pk_bf16(v1[2], v1[3]); }
                u32x4 lo, hi;
#pragma unroll
                for (int e = 0; e < 4; ++e) { lo[e] = (unsigned)__builtin_amdgcn_update_dpp((int)w[0][e], (int)w[1][e], 0x128, 0xF, 0xC, false);
                                              hi[e] = (unsigned)__builtin_amdgcn_update_dpp((int)w[1][e], (int)w[0][e], 0x128, 0xF, 0x3, false); }
                *(u32x4*)rowp = lo; *(u32x4*)(rowp + (size_t)8 * ldc) = hi; }
    }
#ifdef EPI_DUMMY
    __device__ __forceinline__ void dummy(const f32x4 (&acc)[2][2][4][2], const Unit& u, int wr, int wc, int fr, int fq, bf16_t* D) const {
        const int row0 = (u.pm & 15) * BM + wr * 64 + fr, col0 = u.pn * BM + wc * 32 + 8 * fq;
        const int lin = ((u.pm * 16 + u.pn) & 127) * 8 + wr * 4 + wc;
#pragma unroll
        for (int ai = 0; ai < 2; ++ai)
#pragma unroll
            for (int m = 0; m < 4; ++m) { bf16_t* rowp = D + (size_t)(row0 + ai * HALF + m * 16) * ldc + col0;
#pragma unroll
                for (int bj = 0; bj < 2; ++bj) { const f32x4 v0 = acc[ai][bj][m][0], v1 = acc[ai][bj][m][1];
                    u32x4 w; w.x = cvt_pk_bf16(v0[0], v0[1]); w.y = cvt_pk_bf16(v0[2], v0[3]); w.z = cvt_pk_bf16(v1[0], v1[1]); w.w = cvt_pk_bf16(v1[2], v1[3]);
                    if (EPI_DUMMY == 1) *(u32x4*)(rowp + bj * HALF) = w;
                    else *(u32x4*)(D + (size_t)lin * 8192 + ((ai * 4 + m) * 2 + bj) * 512 + (fq * 16 + fr) * 8) = w; } }
    }
#endif
};
struct EpiResGate {
    static constexpr bool PERM = false, AFTER_DRAIN = false, IDEMP = false, HAS_DUMMY = false, PERM64 = false;
    const float* res; float* out; const float* gate; int gpitch;
    __device__ __forceinline__ void operator()(const f32x4 (&acc)[2][2][4][2], const Unit& u, int wr, int wc, int fr, int fq) const {
        const int row0 = u.pm * BM + wr * 64 + fr, col0 = u.pn * BM + wc * 32 + 4 * fq;
        const float* gp = gate + (size_t)(u.pm >> 3) * gpitch + col0;
        f32x4 gv[2][2];
#pragma unroll
        for (int bj = 0; bj < 2; ++bj)
#pragma unroll
            for (int n = 0; n < 2; ++n) gv[bj][n] = *(const f32x4*)(gp + bj * HALF + n * 16);
#pragma unroll
        for (int ai = 0; ai < 2; ++ai)
#pragma unroll
            for (int m = 0; m < 4; ++m) { const size_t off = (size_t)(row0 + ai * HALF + m * 16) * 1024 + col0;
#pragma unroll
                for (int bj = 0; bj < 2; ++bj)
#pragma unroll
                    for (int n = 0; n < 2; ++n) { const f32x4 r = *(const f32x4*)(res + off + bj * HALF + n * 16);
                        *(f32x4*)(out + off + bj * HALF + n * 16) = r + gv[bj][n] * acc[ai][bj][m][n]; } }
    }
};
struct EpiSwiGLU {
    static constexpr bool PERM = true, AFTER_DRAIN = false, IDEMP = true, HAS_DUMMY = false, PERM64 = false;
    bf16_t* O; int ldc;
    __device__ __forceinline__ void operator()(const f32x4 (&acc)[2][2][4][2], const Unit& u, int wr, int wc, int fr, int fq) const {
        const int row0 = u.pm * BM + wr * 64 + fr, col0 = u.pn * HALF + wc * 32 + 8 * fq;
#pragma unroll
        for (int ai = 0; ai < 2; ++ai)
#pragma unroll
            for (int m = 0; m < 4; ++m) { bf16_t* rowp = O + (size_t)(row0 + ai * HALF + m * 16) * ldc + col0; u32x4 w;
#pragma unroll
                for (int n = 0; n < 2; ++n) { const f32x4 g = acc[ai][0][m][n], up = acc[ai][1][m][n]; f32x4 o;
#pragma unroll
                    for (int e = 0; e < 4; ++e) o[e] = g[e] * up[e] * __builtin_amdgcn_rcpf(1.0f + __expf(-g[e]));
                    w[2 * n] = cvt_pk_bf16(o[0], o[1]); w[2 * n + 1] = cvt_pk_bf16(o[2], o[3]); }
                *(u32x4*)rowp = w; }
    }
};

template <bool RES32> struct EpiResGate16 {
    static constexpr bool PERM = true, AFTER_DRAIN = false, IDEMP = RES32, HAS_DUMMY = false, PERM64 = false;
    const void* res; bf16_t* out; const float* gate; int gpitch;
    __device__ __forceinline__ void operator()(const f32x4 (&acc)[2][2][4][2], const Unit& u, int wr, int wc, int fr, int fq) const {
        const int row0 = u.pm * BM + wr * 64 + fr, col0 = u.pn * BM + wc * 32 + 8 * fq;
        const float* gp = gate + (size_t)(u.pm >> 3) * gpitch + col0;
        f32x4 gv[2][2];
#pragma unroll
        for (int bj = 0; bj < 2; ++bj)
#pragma unroll
            for (int n = 0; n < 2; ++n) gv[bj][n] = *(const f32x4*)(gp + bj * HALF + n * 4);
#pragma unroll
        for (int ai = 0; ai < 2; ++ai)
#pragma unroll
            for (int m = 0; m < 4; ++m) { const size_t off = (size_t)(row0 + ai * HALF + m * 16) * 1024 + col0;
#pragma unroll
                for (int bj = 0; bj < 2; ++bj) {
                    f32x4 r0, r1;
                    if (RES32) { r0 = *(const f32x4*)((const float*)res + off + bj * HALF); r1 = *(const f32x4*)((const float*)res + off + bj * HALF + 4); }
                    else { const u32x4 rb = *(const u32x4*)((const bf16_t*)res + off + bj * HALF);
                        r0 = (f32x4){__builtin_bit_cast(float, rb.x << 16), __builtin_bit_cast(float, rb.x & 0xffff0000u), __builtin_bit_cast(float, rb.y << 16), __builtin_bit_cast(float, rb.y & 0xffff0000u)};
                        r1 = (f32x4){__builtin_bit_cast(float, rb.z << 16), __builtin_bit_cast(float, rb.z & 0xffff0000u), __builtin_bit_cast(float, rb.w << 16), __builtin_bit_cast(float, rb.w & 0xffff0000u)}; }
                    const f32x4 v0 = r0 + gv[bj][0] * acc[ai][bj][m][0], v1 = r1 + gv[bj][1] * acc[ai][bj][m][1];
                    u32x4 w; w.x = cvt_pk_bf16(v0[0], v0[1]); w.y = cvt_pk_bf16(v0[2], v0[3]); w.z = cvt_pk_bf16(v1[0], v1[1]); w.w = cvt_pk_bf16(v1[2], v1[3]);
                    *(u32x4*)(out + off + bj * HALF) = w; } }
    }
};

template <class Epi, class Sched, bool ALIGN_EPI = false, bool SP2 = false>
__device__ __forceinline__ void gemm_phase(PG8_LAS unsigned char* lds, const Gemm g, const Sched& S, const Epi& E, const int wid_in  ) {
    int tid_; asm volatile("v_mbcnt_lo_u32_b32 %0, -1, 0\n\tv_mbcnt_hi_u32_b32 %0, -1, %0" : "=v"(tid_)); tid_ += 64 * wid_in;
    const int tid = tid_, wid = wid_in, lane = tid & 63, wr = wid >> 2, wc = wid & 3, fr = lane & 15, fq = lane >> 4;
    const int K = g.K, nt = K / BK;
    unsigned voffA[2], voffB[2];
#pragma unroll
    for (int i = 0; i < 2; ++i) { int R, C; stage_rc(tid * 16 + i * 8192, R, C); const int Rb = Epi::PERM64 ? (64 * (R >> 5) + perm32(R & 31)) : Epi::PERM ? ((R & ~31) + perm32(R & 31)) : R;
        voffA[i] = (unsigned)(R * K + C) * 2u; voffB[i] = (unsigned)(Rb * K + C) * 2u; }
    const size_t kstep = (size_t)(BK * 2);
    const size_t hstep = (size_t)HALF * K * 2;
    const size_t tstep = 2 * hstep;
    const size_t bhstep = Epi::PERM64 ? (size_t)32 * K * 2 : hstep;
    const unsigned ldsw = (unsigned)wid * 1024u;
    const int aoff = lds_byte(wr * 64 + fr, fq * 8), boff = lds_byte(wc * 32 + fr, fq * 8);
#define PG8_SA(b, h) (((b) * 2 + (h)) * HTB)
#define PG8_SB(b, h) ((4 + (b) * 2 + (h)) * HTB)
#define PG8_STAGE(bufoff, gbase, voff) do { _Pragma("unroll") for (int _i = 0; _i < 2; ++_i) \
        __builtin_amdgcn_global_load_lds((const unsigned*)((const char*)(gbase) + (voff)[_i]), (PG8_LAS unsigned*)(lds + (bufoff) + ldsw + _i * 8192), 16, 0, 0); } while (0)
#define PG8_LDA(dst, b, h) do { _Pragma("unroll") for (int m = 0; m < 4; ++m) _Pragma("unroll") for (int k = 0; k < 2; ++k) dst[m][k] = *(const PG8_LAS bf16x8*)(lds + PG8_SA(b, h) + aoff + m * 2048 + k * 1024); } while (0)
#define PG8_LDB(dst, b, h) do { _Pragma("unroll") for (int n = 0; n < 2; ++n) _Pragma("unroll") for (int k = 0; k < 2; ++k) dst[n][k] = *(const PG8_LAS bf16x8*)(lds + PG8_SB(b, h) + boff + n * 2048 + k * 1024); } while (0)
#define PG8_MMA(ai, bj, At, Bt) do { __builtin_amdgcn_s_setprio(1); _Pragma("unroll") for (int m = 0; m < 4; ++m) _Pragma("unroll") for (int n = 0; n < 2; ++n) _Pragma("unroll") for (int k = 0; k < 2; ++k) \
        acc[ai][bj][m][n] = __builtin_amdgcn_mfma_f32_16x16x32_bf16(Bt[n][k], At[m][k], acc[ai][bj][m][n], 0, 0, 0); __builtin_amdgcn_s_setprio(0); } while (0)
#define PG8_WAIT_V(n) asm volatile("s_waitcnt vmcnt(" #n ")" ::: "memory")
#define PG8_WAIT_L(n) asm volatile("s_waitcnt lgkmcnt(" #n ")" ::: "memory")
#define PG8_BAR __builtin_amdgcn_s_barrier()
#define PG8_SCHED __builtin_amdgcn_sched_barrier(0)
    Unit cur, nxt; int ui = 0;
    if (!S.next(0, cur)) return;
    f32x4 acc[2][2][4][2];
#pragma unroll
    for (int a = 0; a < 2; ++a)
#pragma unroll
        for (int b = 0; b < 2; ++b)
#pragma unroll
            for (int m = 0; m < 4; ++m)
#pragma unroll
                for (int n = 0; n < 2; ++n) acc[a][b][m][n] = (f32x4){0.f, 0.f, 0.f, 0.f};
    bf16x8 At[4][2], B0[2][2], B1[2][2];
    const char* cA = (const char*)g.A + (size_t)cur.pm * tstep; const char* cB = (const char*)g.Bt + (size_t)cur.pn * tstep;
    S.a_ready(cur);
    if constexpr (SP2) {
        PG8_STAGE(PG8_SB(0, 0), cB, voffB); PG8_STAGE(PG8_SB(0, 1), cB + bhstep, voffB); PG8_STAGE(PG8_SA(0, 0), cA, voffA); PG8_STAGE(PG8_SA(0, 1), cA + hstep, voffA);
        if (wr == 1) PG8_BAR;
        PG8_WAIT_V(2); PG8_BAR;
        PG8_STAGE(PG8_SB(1, 0), cB + kstep, voffB); PG8_STAGE(PG8_SA(1, 0), cA + kstep, voffA); PG8_STAGE(PG8_SB(1, 1), cB + bhstep + kstep, voffB);
        PG8_WAIT_V(6); PG8_BAR;
    } else {
        PG8_STAGE(PG8_SB(0, 0), cB, voffB); PG8_STAGE(PG8_SA(0, 0), cA, voffA); PG8_STAGE(PG8_SB(0, 1), cB + bhstep, voffB); PG8_STAGE(PG8_SA(0, 1), cA + hstep, voffA);
        if (wr == 1) PG8_BAR;
        PG8_WAIT_V(4); PG8_BAR;
        PG8_STAGE(PG8_SB(1, 0), cB + kstep, voffB); PG8_STAGE(PG8_SA(1, 0), cA + kstep, voffA); PG8_STAGE(PG8_SB(1, 1), cB + bhstep + kstep, voffB);
        PG8_WAIT_V(6); PG8_BAR;
    }
    for (;;) {
        const bool has_next = S.next(ui + 1, nxt);
        const char* nA = has_next ? (const char*)g.A + (size_t)nxt.pm * tstep : cA; const char* nB = has_next ? (const char*)g.Bt + (size_t)nxt.pn * tstep : cB;
        for (int t = 0; t < nt; t += 2) {
            const bool last = (t == nt - 2);
            const char* a1 = cA + (size_t)(t + 1) * kstep;
            const char* a2 = last ? nA : cA + (size_t)(t + 2) * kstep; const char* b2 = last ? nB : cB + (size_t)(t + 2) * kstep;
            const char* a3 = a2 + kstep; const char* b3 = b2 + kstep;
            if (last && has_next) S.a_ready(nxt);
            if constexpr (SP2) {
            PG8_LDB(B0, 0, 0); PG8_LDB(B1, 0, 1); PG8_SCHED; PG8_LDA(At, 0, 0); PG8_STAGE(PG8_SA(1, 1), a1 + hstep, voffA);
            PG8_WAIT_V(8); PG8_WAIT_L(0); PG8_BAR; PG8_MMA(0, 0, At, B0); PG8_MMA(0, 1, At, B1); PG8_BAR; PG8_SCHED;
            PG8_LDA(At, 0, 1); PG8_STAGE(PG8_SB(0, 0), b2, voffB); PG8_STAGE(PG8_SB(0, 1), b2 + bhstep, voffB); PG8_STAGE(PG8_SA(0, 0), a2, voffA);
            PG8_WAIT_V(8); PG8_WAIT_L(0); PG8_BAR; PG8_MMA(1, 0, At, B0); PG8_MMA(1, 1, At, B1); PG8_BAR; PG8_SCHED;
            PG8_LDB(B0, 1, 0); PG8_LDB(B1, 1, 1); PG8_SCHED; PG8_LDA(At, 1, 0); PG8_STAGE(PG8_SA(0, 1), a2 + hstep, voffA);
            PG8_WAIT_V(8); PG8_WAIT_L(0); PG8_BAR; PG8_MMA(0, 0, At, B0); PG8_MMA(0, 1, At, B1); PG8_BAR; PG8_SCHED;
            PG8_LDA(At, 1, 1); PG8_STAGE(PG8_SB(1, 0), b3, voffB); PG8_STAGE(PG8_SB(1, 1), b3 + bhstep, voffB); PG8_STAGE(PG8_SA(1, 0), a3, voffA);
            PG8_WAIT_V(8); PG8_WAIT_L(0); PG8_BAR; PG8_MMA(1, 0, At, B0); PG8_MMA(1, 1, At, B1); PG8_BAR; PG8_SCHED;
            } else {
            PG8_LDB(B0, 0, 0); PG8_SCHED; PG8_LDA(At, 0, 0); PG8_STAGE(PG8_SA(1, 1), a1 + hstep, voffA);
            PG8_WAIT_L(8); PG8_BAR; PG8_WAIT_L(0); PG8_MMA(0, 0, At, B0); PG8_BAR; PG8_SCHED;
            PG8_LDB(B1, 0, 1); PG8_STAGE(PG8_SB(0, 0), b2, voffB);
            PG8_BAR; PG8_WAIT_L(0); PG8_MMA(0, 1, At, B1); PG8_BAR;
            PG8_LDA(At, 0, 1); PG8_STAGE(PG8_SA(0, 0), a2, voffA);
            PG8_BAR; PG8_WAIT_L(0); PG8_MMA(1, 0, At, B0); PG8_BAR; PG8_SCHED;
            PG8_STAGE(PG8_SB(0, 1), b2 + bhstep, voffB);
            PG8_WAIT_V(6); PG8_BAR; PG8_MMA(1, 1, At, B1); PG8_BAR;
            PG8_LDB(B0, 1, 0); PG8_SCHED; PG8_LDA(At, 1, 0); PG8_STAGE(PG8_SA(0, 1), a2 + hstep, voffA);
            PG8_WAIT_L(8); PG8_BAR; PG8_WAIT_L(0); PG8_MMA(0, 0, At, B0); PG8_BAR; PG8_SCHED;
            PG8_LDB(B1, 1, 1); PG8_STAGE(PG8_SB(1, 0), b3, voffB);
            PG8_BAR; PG8_WAIT_L(0); PG8_MMA(0, 1, At, B1); PG8_BAR;
            PG8_LDA(At, 1, 1); PG8_STAGE(PG8_SA(1, 0), a3, voffA);
            PG8_BAR; PG8_WAIT_L(0); PG8_MMA(1, 0, At, B0); PG8_BAR; PG8_SCHED;
            PG8_STAGE(PG8_SB(1, 1), b3 + bhstep, voffB);
            PG8_WAIT_V(6); PG8_BAR; PG8_MMA(1, 1, At, B1); PG8_BAR;
            }
        }
        if constexpr (ALIGN_EPI) { if (wr == 0) PG8_BAR; }
#ifdef REP_K
        if (!cur.skip)
#endif
        if constexpr (!Epi::AFTER_DRAIN) { E(acc, cur, wr, wc, fr, fq);
#ifdef REP_EPI
#ifdef EPI_DUMMY
            if constexpr (Epi::HAS_DUMMY) { asm volatile("" ::: "memory"); E.dummy(acc, cur, wr, wc, fr, fq, (bf16_t*)g.dummy); }
#else
            if constexpr (Epi::IDEMP) { asm volatile("" ::: "memory"); E(acc, cur, wr, wc, fr, fq); }
#endif
#endif
            S.done(cur); }
        if (!has_next) break;
#pragma unroll
        for (int a = 0; a < 2; ++a)
#pragma unroll
            for (int b = 0; b < 2; ++b)
#pragma unroll
                for (int m = 0; m < 4; ++m)
#pragma unroll
                    for (int n = 0; n < 2; ++n) acc[a][b][m][n] = (f32x4){0.f, 0.f, 0.f, 0.f};
        cur = nxt; cA = nA; cB = nB; ++ui;
        if constexpr (ALIGN_EPI) { if (wr == 1) PG8_BAR; }
    }
    PG8_WAIT_V(0);
    if constexpr (!ALIGN_EPI) { if (wr == 0) PG8_BAR; }
    PG8_BAR;
    if constexpr (Epi::AFTER_DRAIN) { E.fused(acc, cur, wr, wc, fr, fq, lds, wid, lane); S.done(cur); }
#undef PG8_SA
#undef PG8_SB
#undef PG8_STAGE
#undef PG8_LDA
#undef PG8_LDB
#undef PG8_MMA
#undef PG8_WAIT_V
#undef PG8_WAIT_L
#undef PG8_BAR
#undef PG8_SCHED
}
}

constexpr int NB = 16, SEQ = 2048, DM = 1024, MROWS = NB * SEQ;
constexpr int IN0P = 2560, IN1P = 2048, IN0 = 2328, IN1 = 1864, DFF = 2816;
constexpr int NTHR = 512, NWV = 8;
constexpr int C_AGATE = 0, C_AX = 512, C_Q = 1024, C_KC = 1536, C_VC = 1664, C_KS = 1792, C_VS = 1920, C_KW = 2048, C_VW = 2176, C_GT = 2304;
constexpr int D_Q = 0, D_K = 1024, D_V = 1152, D_QI = 1280, D_KI = 1792, D_WI = 1856;

constexpr size_t MiB = 1u << 20;
constexpr size_t WS_MOD0 = 64 * 1024, WS_MOD1 = WS_MOD0 + 16 * 6144 * 4, WS_CB1 = WS_MOD1 + 16 * 6144 * 4;
constexpr size_t WS_WIN0 = 4 * MiB, WS_WOUT0 = 9 * MiB, WS_WGU0 = 11 * MiB, WS_WD0 = 22 * MiB;
constexpr size_t WS_WIN1 = 28 * MiB, WS_WOUT1 = 32 * MiB, WS_WGU1 = 34 * MiB, WS_WD1 = 45 * MiB;
constexpr size_t WS_CW1K = 51 * MiB, WS_CW1V = WS_CW1K + 512 * 1024, WS_CW2K = 52 * MiB, WS_CW2V = WS_CW2K + 64 * 1024, WS_WAT = WS_CW2V + 64 * 1024, WS_WXT = WS_WAT + 64 * 1024;
constexpr size_t WS_XN = 56 * MiB;
constexpr size_t WS_BIG = 120 * MiB;
constexpr size_t WS_Y = 296 * MiB;
constexpr size_t WS_HL = 360 * MiB;
constexpr size_t WS_PC = 392 * MiB;
constexpr size_t WS_X16 = 424 * MiB;
constexpr size_t WS_KC = 488 * MiB, WS_VC = WS_KC + 512 * 1024;
constexpr size_t WS_MASK = 489 * MiB;
constexpr size_t WS_END = 497 * MiB;

constexpr int LDS_BYTES = 151552;

#define LAS __attribute__((address_space(3)))
typedef unsigned short bf16;
typedef short bf16x8 __attribute__((ext_vector_type(8)));
typedef short s16x4 __attribute__((ext_vector_type(4)));
typedef float f32x4 __attribute__((ext_vector_type(4)));
typedef float f32x16 __attribute__((ext_vector_type(16)));
typedef unsigned u32x4 __attribute__((ext_vector_type(4)));
typedef unsigned u32x2 __attribute__((ext_vector_type(2)));
#define DI __device__ __forceinline__
#define MFMA32(a, b, c) __builtin_amdgcn_mfma_f32_32x32x16_bf16((a), (b), (c), 0, 0, 0)

DI unsigned pk2(float lo, float hi) { return pg8::cvt_pk_bf16(lo, hi); }
DI bf16 f2bf(float f) { return (bf16)(pk2(f, 0.f) & 0xffffu); }
DI float bf2f(bf16 u) { return __uint_as_float((unsigned)u << 16); }
DI int crow(int r, int hi) { return (r & 3) + 8 * (r >> 2) + 4 * hi; }
DI float sigmoidf_(float x) { return __builtin_amdgcn_rcpf(1.0f + __expf(-x)); }
DI float gelu_tanh(float x) { const float z = 0.7978845608028654f * (x + 0.044715f * x * x * x); return x * sigmoidf_(2.0f * z); }
#define dppf(v, ctrl) __int_as_float(__builtin_amdgcn_update_dpp(0, __float_as_int(v), (ctrl), 0xf, 0xf, true))
#define DPP_XOR1 0xB1
#define DPP_XOR2 0x4E
#define DPP_HMIR 0x141
#define DPP_MIR  0x140
DI float xor16f(float v, bool oddrow) { auto rr = __builtin_amdgcn_permlane16_swap(__float_as_uint(v), __float_as_uint(v), false, false); return __uint_as_float(oddrow ? rr[0] : rr[1]); }
DI float wave_sum(float v) {
    v += dppf(v, DPP_XOR1); v += dppf(v, DPP_XOR2); v += dppf(v, DPP_HMIR); v += dppf(v, DPP_MIR);
    { auto rr = __builtin_amdgcn_permlane16_swap(__float_as_uint(v), __float_as_uint(v), false, false); v = __uint_as_float(rr[0]) + __uint_as_float(rr[1]); }
    { auto rr = __builtin_amdgcn_permlane32_swap(__float_as_uint(v), __float_as_uint(v), false, false); v = __uint_as_float(rr[0]) + __uint_as_float(rr[1]); }
    return v;
}
DI float max_x32(float v) { auto rr = __builtin_amdgcn_permlane32_swap(__float_as_uint(v), __float_as_uint(v), false, false); return fmaxf(__uint_as_float(rr[0]), __uint_as_float(rr[1])); }
DI float sum_x32(float v) { auto rr = __builtin_amdgcn_permlane32_swap(__float_as_uint(v), __float_as_uint(v), false, false); return __uint_as_float(rr[0]) + __uint_as_float(rr[1]); }
DI s16x4 vtr(const LAS char* p) { typedef short v4i16_t __attribute__((ext_vector_type(4))); return __builtin_bit_cast(s16x4, __builtin_amdgcn_ds_read_tr16_b64_v4i16((LAS v4i16_t*)p)); }

DI int opaque(int v) { asm volatile("" : "+v"(v)); return v; }
DI void lds_barrier() { asm volatile("s_waitcnt lgkmcnt(0)" ::: "memory"); __builtin_amdgcn_s_barrier(); asm volatile("" ::: "memory"); }
DI int fresh_lane() { int l; asm volatile("v_mbcnt_lo_u32_b32 %0, -1, 0\n\tv_mbcnt_hi_u32_b32 %0, -1, %0" : "=v"(l)); return l; }
struct Args { const float* in[34]; float* out; unsigned char* ws; };

struct Frame {
    LAS unsigned char* lds;
    int tid, lane, wave, G, bid;
    const float* const* in;
    float* out; unsigned char* ws;
};

#define GAS __attribute__((address_space(1)))
typedef GAS unsigned gu32;
typedef GAS unsigned long long gu64;
#define RLX_AGENT __ATOMIC_RELAXED, __HIP_MEMORY_SCOPE_AGENT
#define LDS_WAIT() asm volatile("s_waitcnt lgkmcnt(0)" ::: "memory")
#define VM_WAIT() asm volatile("s_waitcnt vmcnt(0)" ::: "memory")
__device__ __forceinline__ unsigned long long rt() { return __builtin_amdgcn_s_memrealtime(); }
#define XB_TMO      128
#define XB_XCNT(j)  (256  + 64 * (j))
#define XB_XSUB(j)  (1280 + 64 * (j))
#define XB_XGEN(j)  (2304 + 64 * (j))
#define XB_TOP      3328
#define XB_TOPGEN   3392
#define XCD_BAR_WORDS 3456
#define XB_SPIN_CAP (1u << 18)

__device__ __forceinline__ unsigned xb_ld(unsigned* p)              { return __hip_atomic_load(p, __ATOMIC_RELAXED, __HIP_MEMORY_SCOPE_AGENT); }
__device__ __forceinline__ unsigned xb_add(unsigned* p, unsigned v) { return __hip_atomic_fetch_add(p, v, __ATOMIC_RELAXED, __HIP_MEMORY_SCOPE_AGENT); }
__device__ __forceinline__ unsigned xb_xcc_id() { return (unsigned)__builtin_amdgcn_s_getreg((3 << 11) | 20) & 0xFu; }
#define XB_SPIN(cond, bar) do { unsigned _sp = 0; while (cond) { __builtin_amdgcn_s_sleep(1); \
    if ((++_sp & 255u) == 0u) { if (xb_ld(&(bar)[XB_TMO])) break; if (_sp > XB_SPIN_CAP) { atomicAdd(&(bar)[XB_TMO], 1u); break; } } } } while (0)

struct XcdBarrier {
    unsigned* bar; unsigned x;
    volatile LAS unsigned* st;
};

__device__ __forceinline__ XcdBarrier xcd_barrier_post(unsigned* bar, volatile LAS unsigned* st) {
    XcdBarrier b; b.bar = bar; b.x = xb_xcc_id(); b.st = st;
    if (threadIdx.x == 0) (void)xb_add(&bar[XB_XCNT(b.x)], 1u);
    return b;
}
__device__ __forceinline__ void xcd_barrier_complete(unsigned* bar, unsigned x, unsigned& nloc, unsigned& nx) {
    const unsigned G = gridDim.x * gridDim.y * gridDim.z;
    unsigned sum, cnt, mine, sp = 0u;
    for (;;) {
        sum = 0u; cnt = 0u; mine = 0u;
#pragma unroll
        for (unsigned j = 0; j < 16; ++j) { const unsigned c = xb_ld(&bar[XB_XCNT(j)]); sum += c; cnt += (c > 0u) ? 1u : 0u; mine = (j == x) ? c : mine; }
        if (sum == G) break;
        __builtin_amdgcn_s_sleep(1);
        if ((++sp & 255u) == 0u) { if (xb_ld(&bar[XB_TMO])) break; if (sp > XB_SPIN_CAP) { atomicAdd(&bar[XB_TMO], 1u); break; } }
    }
    nloc = mine > 0u ? mine : 1u; nx = cnt > 0u ? cnt : 1u;
}

__device__ __forceinline__ void xcd_barrier(const XcdBarrier& b) {
    asm volatile("s_waitcnt vmcnt(0)" ::: "memory");
    __syncthreads();
    if (threadIdx.x == 0) {
        unsigned* bar = b.bar;
        __builtin_amdgcn_s_waitcnt(0);
        unsigned nloc = b.st[0], nx = b.st[1];
        if (nloc == 0u) { xcd_barrier_complete(bar, b.x, nloc, nx); b.st[0] = nloc; b.st[1] = nx; }
        const unsigned old = xb_add(&bar[XB_XSUB(b.x)], 1u);
        const unsigned gen = old / nloc;
        if (old + 1u == (gen + 1u) * nloc) {
            __builtin_amdgcn_fence(__ATOMIC_RELEASE, "agent");
            asm volatile("s_waitcnt vmcnt(0)" ::: "memory");
            const unsigned og = xb_add(&bar[XB_TOP], 1u);
            const unsigned tg = og / nx;
            if (og + 1u == (tg + 1u) * nx) xb_add(&bar[XB_TOPGEN], 1u);
            else XB_SPIN(xb_ld(&bar[XB_TOPGEN]) == tg, bar);
            __builtin_amdgcn_fence(__ATOMIC_ACQUIRE, "agent");
            xb_add(&bar[XB_XGEN(b.x)], 1u);
            asm volatile("s_waitcnt vmcnt(0)" ::: "memory");
        } else {
            XB_SPIN(xb_ld(&bar[XB_XGEN(b.x)]) == gen, bar);
            __builtin_amdgcn_fence(__ATOMIC_ACQUIRE, "agent");
            asm volatile("s_waitcnt vmcnt(0)" ::: "memory");
        }
    }
    __syncthreads();
}

#define GB_CNT(g)  (4096 + 64 * (g))
#define XG_CNT(x)  (6144 + 64 * (x))
#define GB_SPLIT(i) (6656 + 64 * (i))
#define GB_XID(c)  (6912 + (c))
struct GrpBarrier { unsigned* bar; unsigned cnt, n; volatile LAS unsigned* fastw; };
__device__ __forceinline__ void grp_barrier(const GrpBarrier& b, unsigned epoch) {
    asm volatile("s_waitcnt vmcnt(0)" ::: "memory");
    __syncthreads();
    if (threadIdx.x == 0) {
        unsigned* bar = b.bar;
        __builtin_amdgcn_s_waitcnt(0);
        if (*b.fastw != 2u) { __builtin_amdgcn_fence(__ATOMIC_RELEASE, "agent"); asm volatile("s_waitcnt vmcnt(0)" ::: "memory"); }
        (void)xb_add(&bar[b.cnt], 1u);
        const unsigned target = b.n * epoch;
        XB_SPIN(xb_ld(&bar[b.cnt]) < target, bar);
        __builtin_amdgcn_fence(__ATOMIC_ACQUIRE, "agent");
        asm volatile("s_waitcnt vmcnt(0)" ::: "memory");
    }
    __syncthreads();
}
__device__ __forceinline__ void split_arrive(unsigned* bar, int i) { if (threadIdx.x == 0) (void)xb_add(&bar[GB_SPLIT(i)], 1u); }
__device__ __forceinline__ void split_wait(unsigned* bar, int i, unsigned G) { if (threadIdx.x == 0) { XB_SPIN(xb_ld(&bar[GB_SPLIT(i)]) < G, bar); } __syncthreads(); }
template <int MODE  >
DI void transpose_item(const float* W, int K, int N, bf16* WT, int row_off, LAS float* scr, int item, int lane) {
    const int nblk = (N + 31) / 32, kb = item / nblk, nb = item % nblk, k0 = 64 * kb, n0 = 32 * nb;
    const int nn = n0 + (lane & 31);
#pragma unroll 8
    for (int i = 0; i < 32; ++i) { const int kk = 2 * i + (lane >> 5); scr[kk * 33 + (lane & 31)] = (nn < N) ? W[(size_t)(k0 + kk) * N + nn] : 0.f; }
    asm volatile("s_waitcnt lgkmcnt(0)" ::: "memory");
    const int c = lane & 7;
#pragma unroll
    for (int j = 0; j < 4; ++j) { const int n = (lane >> 3) + 8 * j; const LAS float* s = scr + (8 * c) * 33 + n;
        u32x4 o; o.x = pk2(s[0 * 33], s[1 * 33]); o.y = pk2(s[2 * 33], s[3 * 33]); o.z = pk2(s[4 * 33], s[5 * 33]); o.w = pk2(s[6 * 33], s[7 * 33]);
        const int ng = n0 + n;
        int dr;
        if (MODE == 0) dr = row_off + ng; else if (MODE == 1) dr = (ng >> 7) * 256 + (ng & 127); else dr = (ng >> 7) * 256 + 128 + (ng & 127);
        if (ng < N) *(u32x4*)(WT + (size_t)dr * K + k0 + 8 * c) = o; }
    asm volatile("s_waitcnt lgkmcnt(0)" ::: "memory");
}

DI void p0_adaln_item(Frame& F, int it) {
    const int l = it / 96, n0 = 64 * (it % 96);
    const float* c = F.in[1]; const float* W = F.in[l ? 26 : 4]; const float* bias = F.in[l ? 27 : 5];
    float* MOD = (float*)(F.ws + (l ? WS_MOD1 : WS_MOD0));
    LAS float* sc = (LAS float*)F.lds;
    LAS float* red = (LAS float*)(F.lds + 66048);
    for (int e = F.tid; e < 16 * 1024; e += NTHR) { const int b = e >> 10, k = e & 1023; const float v = c[e]; sc[b * 1028 + k] = v * sigmoidf_(v); }
    __syncthreads();
    const int lane = F.lane, w = F.wave, cb = w & 1, kq = w >> 1, r32 = lane & 31, hi = lane >> 5;
    f32x16 acc;
#pragma unroll
    for (int r = 0; r < 16; ++r) acc[r] = 0.f;
    const float* wp = W + (size_t)(kq * 256 + hi) * 6144 + n0 + cb * 32 + r32;
    const LAS float* ap = sc + (r32 & 15) * 1028 + kq * 256 + hi;
#pragma unroll 16
    for (int s2 = 0; s2 < 128; ++s2) acc = __builtin_amdgcn_mfma_f32_32x32x2f32(ap[2 * s2], wp[(size_t)(2 * s2) * 6144], acc, 0, 0, 0);
#pragma unroll
    for (int r = 0; r < 8; ++r) red[((kq * 2 + cb) * 8 + r) * 64 + lane] = acc[r];
    __syncthreads();
    if (kq == 0) {
#pragma unroll
        for (int r = 0; r < 8; ++r) { float v = 0.f;
#pragma unroll
            for (int q = 0; q < 4; ++q) v += red[((q * 2 + cb) * 8 + r) * 64 + lane];
            const int b = crow(r, hi), n = n0 + cb * 32 + r32;
            MOD[b * 6144 + n] = v + bias[n]; }
    }
    __syncthreads();
}
DI void p0_cb1_item(Frame& F, int it) {
    const int kv = it >> 1, n0 = 64 * (it & 1);
    const float* pe = F.in[kv ? 17 : 14]; const float* W = F.in[kv ? 18 : 15];
    float* CB1 = (float*)(F.ws + WS_CB1);
    LAS float* red = (LAS float*)F.lds;
    const int col = F.tid & 63, kg = F.tid >> 6;
    float acc = 0.f;
    for (int k = kg * 256; k < kg * 256 + 256; ++k) acc += pe[k] * W[(size_t)k * 128 + n0 + col];
    red[kg * 64 + col] = acc;
    __syncthreads();
    if (F.tid < 64) { float s = 0.f;
#pragma unroll
        for (int g = 0; g < 8; ++g) s += red[g * 64 + F.tid];
        CB1[kv * 128 + n0 + F.tid] = s; }
    __syncthreads();
}
DI void p0_prologue(Frame& F) {
    for (int it = F.bid; it < 196; it += F.G) { if (it < 192) p0_adaln_item(F, it); else p0_cb1_item(F, it - 192); }
    __syncthreads();
    LAS float* scr = (LAS float*)(F.lds + F.wave * 16384);
    const int gw = F.bid * NWV + F.wave, NGW = F.G * NWV;
    unsigned char* ws = F.ws;
    constexpr int I_WIN0 = 16 * 73, I_SQ = 16 * 32, I_FF = 16 * 88, I_WD = 44 * 32, I_WIN1 = 16 * 59, I_C1 = 32 * 4, I_C2 = 2 * 2, I_LR = 8 * 2;
    constexpr int NITEMS = I_WIN0 + I_SQ + 2 * I_FF + I_WD + I_WIN1 + I_SQ + 2 * I_FF + I_WD + 2 * I_C1 + 2 * I_C2 + 2 * I_LR;
    for (int it = gw; it < NITEMS; it += NGW) {
        int r = it;
        if (r < I_WIN0) { transpose_item<0>(F.in[6], 1024, IN0, (bf16*)(ws + WS_WIN0), 0, scr, r, F.lane); continue; } r -= I_WIN0;
        if (r < I_SQ) { transpose_item<0>(F.in[20], 1024, 1024, (bf16*)(ws + WS_WOUT0), 0, scr, r, F.lane); continue; } r -= I_SQ;
        if (r < I_FF) { transpose_item<1>(F.in[21], 1024, DFF, (bf16*)(ws + WS_WGU0), 0, scr, r, F.lane); continue; } r -= I_FF;
        if (r < I_FF) { transpose_item<2>(F.in[22], 1024, DFF, (bf16*)(ws + WS_WGU0), 0, scr, r, F.lane); continue; } r -= I_FF;
        if (r < I_WD) { transpose_item<0>(F.in[23], DFF, 1024, (bf16*)(ws + WS_WD0), 0, scr, r, F.lane); continue; } r -= I_WD;
        if (r < I_WIN1) { transpose_item<0>(F.in[28], 1024, IN1, (bf16*)(ws + WS_WIN1), 0, scr, r, F.lane); continue; } r -= I_WIN1;
        if (r < I_SQ) { transpose_item<0>(F.in[29], 1024, 1024, (bf16*)(ws + WS_WOUT1), 0, scr, r, F.lane); continue; } r -= I_SQ;
        if (r < I_FF) { transpose_item<1>(F.in[30], 1024, DFF, (bf16*)(ws + WS_WGU1), 0, scr, r, F.lane); continue; } r -= I_FF;
        if (r < I_FF) { transpose_item<2>(F.in[31], 1024, DFF, (bf16*)(ws + WS_WGU1), 0, scr, r, F.lane); continue; } r -= I_FF;
        if (r < I_WD) { transpose_item<0>(F.in[32], DFF, 1024, (bf16*)(ws + WS_WD1), 0, scr, r, F.lane); continue; } r -= I_WD;
        if (r < I_C1) { transpose_item<0>(F.in[15], 2048, 128, (bf16*)(ws + WS_CW1K), 0, scr, r, F.lane); continue; } r -= I_C1;
        if (r < I_C1) { transpose_item<0>(F.in[18], 2048, 128, (bf16*)(ws + WS_CW1V), 0, scr, r, F.lane); continue; } r -= I_C1;
        if (r < I_C2) { transpose_item<0>(F.in[16], 128, 64, (bf16*)(ws + WS_CW2K), 0, scr, r, F.lane); continue; } r -= I_C2;
        if (r < I_C2) { transpose_item<0>(F.in[19], 128, 64, (bf16*)(ws + WS_CW2V), 0, scr, r, F.lane); continue; } r -= I_C2;
        if (r < I_LR) { const int h = r >> 1; transpose_item<0>(F.in[9] + h * 4096, 64, 64, (bf16*)(ws + WS_WAT), h * 64, scr, r & 1, F.lane); continue; } r -= I_LR;
        { const int h = r >> 1; transpose_item<0>(F.in[11] + h * 4096, 64, 64, (bf16*)(ws + WS_WXT), h * 64, scr, r & 1, F.lane); }
    }
    {
        const int gt = F.bid * NTHR + F.tid, NGT = F.G * NTHR;
        u32x4* z0 = (u32x4*)(ws + WS_WIN0 + (size_t)IN0 * 1024 * 2); const int n0 = (IN0P - IN0) * 1024 * 2 / 16;
        for (int i = gt; i < n0; i += NGT) z0[i] = (u32x4){0u, 0u, 0u, 0u};
        u32x4* z1 = (u32x4*)(ws + WS_WIN1 + (size_t)IN1 * 1024 * 2); const int n1 = (IN1P - IN1) * 1024 * 2 / 16;
        for (int i = gt; i < n1; i += NGT) z1[i] = (u32x4){0u, 0u, 0u, 0u};
    }
}

DI void norm_mod_phase(Frame& F, const float* X, const float* g, const float* shift, const float* scale, bf16* XN, int r0, int nr) {
    for (int m0 = r0 + F.wave * 2; m0 < r0 + nr; m0 += NWV * 2) {
        const int b = m0 >> 11;
        f32x4 v[2][4];
#pragma unroll
        for (int r = 0; r < 2; ++r) { const f32x4* xr = (const f32x4*)(X + (size_t)(m0 + r) * DM) + F.lane;
#pragma unroll
            for (int j = 0; j < 4; ++j) v[r][j] = xr[64 * j]; }
        f32x4 gg[4], sh[4];
#pragma unroll
        for (int j = 0; j < 4; ++j) { gg[j] = ((const f32x4*)g)[F.lane + 64 * j] * (((const f32x4*)(scale + (size_t)b * 6144))[F.lane + 64 * j] + 1.0f); sh[j] = ((const f32x4*)(shift + (size_t)b * 6144))[F.lane + 64 * j]; }
#pragma unroll
        for (int r = 0; r < 2; ++r) {
            float s = 0.f;
#pragma unroll
            for (int j = 0; j < 4; ++j) s += (v[r][j].x * v[r][j].x + v[r][j].y * v[r][j].y) + (v[r][j].z * v[r][j].z + v[r][j].w * v[r][j].w);
            const float rstd = __builtin_amdgcn_rsqf(wave_sum(s) * (1.f / DM) + 1e-6f);
            u32x2* o8 = (u32x2*)(XN + (size_t)(m0 + r) * DM) + F.lane;
#pragma unroll
            for (int j = 0; j < 4; ++j) { const f32x4 y = v[r][j] * rstd * gg[j] + sh[j]; u32x2 w; w.x = pk2(y[0], y[1]); w.y = pk2(y[2], y[3]); o8[64 * j] = w; }
        }
    }
}
DI void norm_mod_phase16(Frame& F, const bf16* X, const float* g, const float* shift, const float* scale, bf16* XN, int r0, int nr) {
    for (int m0 = r0 + F.wave * 4; m0 < r0 + nr; m0 += NWV * 4) {
        const int b = m0 >> 11;
        u32x4 u[4][2];
#pragma unroll
        for (int r = 0; r < 4; ++r) { const u32x4* xr = (const u32x4*)(X + (size_t)(m0 + r) * DM) + F.lane; u[r][0] = xr[0]; u[r][1] = xr[64]; }
        f32x4 gg[4], sc[4], sh[4];
#pragma unroll
        for (int q = 0; q < 4; ++q) { const int c0 = 512 * (q >> 1) + 8 * F.lane + 4 * (q & 1); gg[q] = *(const f32x4*)(g + c0); sc[q] = *(const f32x4*)(scale + (size_t)b * 6144 + c0); sh[q] = *(const f32x4*)(shift + (size_t)b * 6144 + c0); }
#pragma unroll
        for (int q = 0; q < 4; ++q) gg[q] = gg[q] * (sc[q] + 1.0f);
#pragma unroll
        for (int r = 0; r < 4; ++r) {
            float v[16]; float s = 0.f;
#pragma unroll
            for (int j = 0; j < 2; ++j)
#pragma unroll
                for (int e = 0; e < 4; ++e) { v[8 * j + 2 * e] = __uint_as_float(u[r][j][e] << 16); v[8 * j + 2 * e + 1] = __uint_as_float(u[r][j][e] & 0xffff0000u); }
#pragma unroll
            for (int e = 0; e < 16; ++e) s += v[e] * v[e];
            const float rstd = __builtin_amdgcn_rsqf(wave_sum(s) * (1.f / DM) + 1e-6f);
            u32x4* o8 = (u32x4*)(XN + (size_t)(m0 + r) * DM) + F.lane;
#pragma unroll
            for (int j = 0; j < 2; ++j) {
                float y[8];
#pragma unroll
                for (int q = 0; q < 2; ++q)
#pragma unroll
                    for (int e = 0; e < 4; ++e) y[4 * q + e] = v[8 * j + 4 * q + e] * rstd * gg[2 * j + q][e] + sh[2 * j + q][e];
                u32x4 w; w.x = pk2(y[0], y[1]); w.y = pk2(y[2], y[3]); w.z = pk2(y[4], y[5]); w.w = pk2(y[6], y[7]); o8[64 * j] = w;
            }
        }
    }
}
DI void final_norm_phase16(Frame& F, const bf16* X, float* out, const float* g, int r0, int nr) {
    f32x4 gg[4];
#pragma unroll
    for (int q = 0; q < 4; ++q) gg[q] = *(const f32x4*)(g + 512 * (q >> 1) + 8 * F.lane + 4 * (q & 1));
    for (int m0 = r0 + F.wave * 4; m0 < r0 + nr; m0 += NWV * 4) {
        u32x4 u[4][2];
#pragma unroll
        for (int r = 0; r < 4; ++r) { const u32x4* xr = (const u32x4*)(X + (size_t)(m0 + r) * DM) + F.lane; u[r][0] = xr[0]; u[r][1] = xr[64]; }
#pragma unroll
        for (int r = 0; r < 4; ++r) {
            float v[16]; float s = 0.f;
#pragma unroll
            for (int j = 0; j < 2; ++j)
#pragma unroll
                for (int e = 0; e < 4; ++e) { v[8 * j + 2 * e] = __uint_as_float(u[r][j][e] << 16); v[8 * j + 2 * e + 1] = __uint_as_float(u[r][j][e] & 0xffff0000u); }
#pragma unroll
            for (int e = 0; e < 16; ++e) s += v[e] * v[e];
            const float rstd = __builtin_amdgcn_rsqf(wave_sum(s) * (1.f / DM) + 1e-6f);
#pragma unroll
            for (int q = 0; q < 4; ++q) { f32x4 o;
#pragma unroll
                for (int e = 0; e < 4; ++e) o[e] = v[4 * q + e] * rstd * gg[q][e];
                *(f32x4*)(out + (size_t)(m0 + r) * DM + 512 * (q >> 1) + 8 * F.lane + 4 * (q & 1)) = o; }
        }
    }
}
DI void final_norm_phase(Frame& F, float* X, const float* g) {
    const int gw = F.bid * NWV + F.wave, NGW = F.G * NWV;
    for (int m = gw; m < MROWS; m += NGW) {
        f32x4* xr = (f32x4*)(X + (size_t)m * DM) + F.lane;
        f32x4 v[4]; float s = 0.f;
#pragma unroll
        for (int j = 0; j < 4; ++j) { v[j] = xr[64 * j]; s += (v[j].x * v[j].x + v[j].y * v[j].y) + (v[j].z * v[j].z + v[j].w * v[j].w); }
        const float rstd = __builtin_amdgcn_rsqf(wave_sum(s) * (1.f / DM) + 1e-6f);
#pragma unroll
        for (int j = 0; j < 4; ++j) { const f32x4 gg = ((const f32x4*)g)[F.lane + 64 * j]; xr[64 * j] = v[j] * rstd * gg; }
    }
}

DI void lru_stage1_item(Frame& F, int item) {
    const int b = item >> 7, h = (item >> 4) & 7, ck = item & 15, t0 = ck * 128;
    const int tid = opaque(F.tid), lane = tid & 63, w = F.wave, r32 = lane & 31, hi = lane >> 5;
    LAS bf16* XCB = (LAS bf16*)F.lds;
    LAS float* XCF = (LAS float*)(F.lds + 18432);
    LAS float* AL = (LAS float*)(F.lds + 18432 + 32768);
    LAS float* UL = (LAS float*)(F.lds + 18432 + 65536);
    LAS float* TOT = (LAS float*)(F.lds + 18432 + 98304);
    LAS bf16* AXT = (LAS bf16*)(F.lds + 18432 + 98304 + 4096);
    const bf16* P1 = (const bf16*)(F.ws + WS_BIG);
    const int tb = w >> 1, cb2 = w & 1;
    bf16x8 wa_f[4], wx_f[4];
    {
        const bf16* WAT = (const bf16*)(F.ws + WS_WAT) + (size_t)(h * 64 + cb2 * 32 + r32) * 64 + hi * 8;
        const bf16* WXT = (const bf16*)(F.ws + WS_WXT) + (size_t)(h * 64 + cb2 * 32 + r32) * 64 + hi * 8;
#pragma unroll
        for (int ks = 0; ks < 4; ++ks) { wa_f[ks] = *(const bf16x8*)(WAT + ks * 16); wx_f[ks] = *(const bf16x8*)(WXT + ks * 16); }
    }
    {
        const bf16* ax = P1 + (size_t)(b * SEQ) * IN0P + C_AX + h * 64;
        const int ch8 = tid & 7;
        u32x4 v[3];
#pragma unroll
        for (int p = 0; p < 3; ++p) { const int rr = (tid >> 3) + 64 * p, t = t0 - 3 + rr; v[p] = (u32x4){0u, 0u, 0u, 0u}; if (rr < 131 && t >= 0) v[p] = *(const u32x4*)(ax + (size_t)t * IN0P + ch8 * 8); }
#pragma unroll
        for (int p = 0; p < 3; ++p) { const int rr = (tid >> 3) + 64 * p; if (rr < 131) *(LAS u32x4*)(AXT + rr * 64 + ch8 * 8) = v[p]; }
    }
    __syncthreads();
    {
        const int c = tid & 63, tg = tid >> 6, ch = h * 64 + c;
        const float* cw = F.in[7]; const float w0 = cw[ch], w1 = cw[512 + ch], w2 = cw[1024 + ch], w3 = cw[1536 + ch], cb = F.in[8][ch];
        float x3 = bf2f(AXT[(tg * 16 + 0) * 64 + c]), x2 = bf2f(AXT[(tg * 16 + 1) * 64 + c]), x1 = bf2f(AXT[(tg * 16 + 2) * 64 + c]);
#pragma unroll 8
        for (int i = 0; i < 16; ++i) {
            const float x0 = bf2f(AXT[(tg * 16 + i + 3) * 64 + c]);
            const float v = w0 * x3 + w1 * x2 + w2 * x1 + w3 * x0 + cb;
            XCF[(tg * 16 + i) * 64 + c] = v; XCB[(tg * 16 + i) * 72 + c] = f2bf(v);
            x3 = x2; x2 = x1; x1 = x0;
        }
    }
    __syncthreads();
    {
        f32x16 accA, accX;
#pragma unroll
        for (int r = 0; r < 16; ++r) { accA[r] = 0.f; accX[r] = 0.f; }
#pragma unroll
        for (int ks = 0; ks < 4; ++ks) {
            const bf16x8 a = *(const LAS bf16x8*)(XCB + (tb * 32 + r32) * 72 + ks * 16 + hi * 8);
            accA = MFMA32(a, wa_f[ks], accA); accX = MFMA32(a, wx_f[ks], accX);
        }
        const int j = cb2 * 32 + r32, chj = h * 64 + j;
        const float ba_ = F.in[10][chj], bx_ = F.in[12][chj];
        const float sp = log1pf(__expf(-F.in[13][chj]));
#pragma unroll
        for (int r = 0; r < 16; ++r) {
            const int tok = tb * 32 + crow(r, hi);
            const float rg = sigmoidf_(accA[r] + ba_), ig = sigmoidf_(accX[r] + bx_);
            const float a = __expf(-8.0f * rg * sp);
            float mult = __builtin_amdgcn_sqrtf(fmaxf(1.0f - a * a, 0.f));
            if (t0 + tok == 0) mult = 1.0f;
            AL[tok * 64 + j] = a; UL[tok * 64 + j] = mult * ig * XCF[tok * 64 + j];
        }
    }
    __syncthreads();
    {
        const int c = tid & 63, tg = tid >> 6, ch = h * 64 + c;
        float P = 1.f, hh = 0.f;
#pragma unroll 8
        for (int i = 0; i < 16; ++i) { const int o = (tg * 16 + i) * 64 + c; const float a = AL[o], u = UL[o]; hh = a * hh + u; P *= a; UL[o] = hh; AL[o] = P; }
        TOT[(tg * 64 + c) * 2] = P; TOT[(tg * 64 + c) * 2 + 1] = hh;
        __syncthreads();
        float Pc = 1.f, hc = 0.f;
        for (int s = 0; s < tg; ++s) { const float p = TOT[(s * 64 + c) * 2], q = TOT[(s * 64 + c) * 2 + 1]; hc = p * hc + q; Pc *= p; }
        bf16* HL = (bf16*)(F.ws + WS_HL); bf16* PCm = (bf16*)(F.ws + WS_PC);
#pragma unroll 8
        for (int i = 0; i < 16; ++i) { const int o = (tg * 16 + i) * 64 + c; const size_t go = (size_t)(b * SEQ + t0 + tg * 16 + i) * 512 + ch;
            HL[go] = f2bf(UL[o] + AL[o] * hc); PCm[go] = f2bf(AL[o] * Pc); }
    }
    __syncthreads();
}
DI void lru_stage2_item(Frame& F, int item) {
    const int b = item >> 4, ck = item & 15, tid = opaque(F.tid), cq = tid & 127, tg = tid >> 7;
    const bf16* HL = (const bf16*)(F.ws + WS_HL); const bf16* PCm = (const bf16*)(F.ws + WS_PC);
    const bf16* P1 = (const bf16*)(F.ws + WS_BIG); bf16* Y = (bf16*)(F.ws + WS_Y);
    u32x2 pv[15], qv[15];
#pragma unroll
    for (int j = 0; j < 15; ++j) { const size_t ro = (size_t)(b * SEQ + (j < ck ? j : 0) * 128 + 127) * 512 + cq * 4; pv[j] = *(const u32x2*)(PCm + ro); qv[j] = *(const u32x2*)(HL + ro); }
    float hc[4] = {0.f, 0.f, 0.f, 0.f};
#pragma unroll
    for (int j = 0; j < 15; ++j) {
        const bool on = j < ck;
        const float p0 = on ? __uint_as_float(pv[j].x << 16) : 1.f, p1 = on ? __uint_as_float(pv[j].x & 0xffff0000u) : 1.f, p2 = on ? __uint_as_float(pv[j].y << 16) : 1.f, p3 = on ? __uint_as_float(pv[j].y & 0xffff0000u) : 1.f;
        const float q0 = on ? __uint_as_float(qv[j].x << 16) : 0.f, q1 = on ? __uint_as_float(qv[j].x & 0xffff0000u) : 0.f, q2 = on ? __uint_as_float(qv[j].y << 16) : 0.f, q3 = on ? __uint_as_float(qv[j].y & 0xffff0000u) : 0.f;
        hc[0] = p0 * hc[0] + q0; hc[1] = p1 * hc[1] + q1; hc[2] = p2 * hc[2] + q2; hc[3] = p3 * hc[3] + q3;
    }
    const size_t row0 = (size_t)(b * SEQ + ck * 128 + tg * 32);
#pragma unroll 8
    for (int i = 0; i < 32; ++i) {
        const size_t row = row0 + i;
        const u32x2 hv = *(const u32x2*)(HL + row * 512 + cq * 4), pc = *(const u32x2*)(PCm + row * 512 + cq * 4), ag = *(const u32x2*)(P1 + row * IN0P + C_AGATE + cq * 4);
        const float h0 = __uint_as_float(hv.x << 16) + __uint_as_float(pc.x << 16) * hc[0], h1 = __uint_as_float(hv.x & 0xffff0000u) + __uint_as_float(pc.x & 0xffff0000u) * hc[1];
        const float h2 = __uint_as_float(hv.y << 16) + __uint_as_float(pc.y << 16) * hc[2], h3 = __uint_as_float(hv.y & 0xffff0000u) + __uint_as_float(pc.y & 0xffff0000u) * hc[3];
        u32x2 o; o.x = pk2(h0 * gelu_tanh(__uint_as_float(ag.x << 16)), h1 * gelu_tanh(__uint_as_float(ag.x & 0xffff0000u)));
        o.y = pk2(h2 * gelu_tanh(__uint_as_float(ag.y << 16)), h3 * gelu_tanh(__uint_as_float(ag.y & 0xffff0000u)));
        *(u32x2*)(Y + row * DM + cq * 4) = o;
    }
}

DI void lru_fused_item(Frame& F, int item) {
    const int b = item >> 4, h = (item >> 1) & 7, cb = item & 1;
    const int tid = opaque(F.tid), lane = tid & 63, w = F.wave, r32 = lane & 31, hi = lane >> 5;
    LAS bf16* AXT = (LAS bf16*)F.lds;
    LAS bf16* AGT = (LAS bf16*)(F.lds + 33536);
    LAS bf16* XCB = (LAS bf16*)(F.lds + 58112);
    LAS bf16* GP = (LAS bf16*)(F.lds + 94976);
    LAS float* TOT = (LAS float*)(F.lds + 127744);
    LAS float* CAR = (LAS float*)(F.lds + 131840);
    const bf16* P1 = (const bf16*)(F.ws + WS_BIG);
    bf16* Y = (bf16*)(F.ws + WS_Y);
    const int tb = w >> 1, gsel = w & 1;
    bf16x8 wf[4];
    {
        const bf16* WT = (const bf16*)(F.ws + (gsel ? WS_WXT : WS_WAT)) + (size_t)(h * 64 + cb * 32 + r32) * 64 + hi * 8;
#pragma unroll
        for (int ks = 0; ks < 4; ++ks) wf[ks] = *(const bf16x8*)(WT + ks * 16);
    }
    const int c = tid & 63, tg = tid >> 6, chc = h * 64 + c;
    const float* cw = F.in[7]; const float w0 = cw[chc], w1 = cw[512 + chc], w2 = cw[1024 + chc], w3 = cw[1536 + chc], cbias = F.in[8][chc];
    const int j = tid & 31, tgp = tid >> 5, chj = h * 64 + cb * 32 + j;
    const float ba_ = F.in[10][chj], bx_ = F.in[12][chj];
    const float sp8 = -8.0f * log1pf(__expf(-F.in[13][chj]));
    const bf16* ax = P1 + (size_t)(b * SEQ) * IN0P + C_AX + h * 64;
    const bf16* ag = P1 + (size_t)(b * SEQ) * IN0P + C_AGATE + h * 64 + cb * 32;
    const int ch8 = tid & 7, row8 = tid >> 3;
    u32x4 pax[3], pag;
#define LRU_PREFETCH(CK) do { const int ck_ = (CK) < 16 ? (CK) : 15; const int t0_ = ck_ * 128; \
        _Pragma("unroll") for (int p = 0; p < 3; ++p) { const int rr = row8 + 64 * p, t = t0_ - 3 + rr; pax[p] = (u32x4){0u, 0u, 0u, 0u}; if (rr < 131 && t >= 0) pax[p] = *(const u32x4*)(ax + (size_t)t * IN0P + ch8 * 8); } \
        pag = *(const u32x4*)(ag + (size_t)(t0_ + (tid >> 2)) * IN0P + (tid & 3) * 8); } while (0)
#define LRU_STORE(CK) do { LAS bf16* axt_ = AXT + ((CK) & 1) * (131 * 64); LAS bf16* agt_ = AGT + ((CK) % 3) * (128 * 32); \
        _Pragma("unroll") for (int p = 0; p < 3; ++p) { const int rr = row8 + 64 * p; if (rr < 131) *(LAS u32x4*)(axt_ + rr * 64 + ch8 * 8) = pax[p]; } \
        *(LAS u32x4*)(agt_ + (tid >> 2) * 32 + (tid & 3) * 8) = pag; } while (0)
#define LRU_CONV(CK) do { const LAS bf16* axt_ = AXT + ((CK) & 1) * (131 * 64); LAS bf16* xcb_ = XCB + ((CK) & 1) * (128 * 72); \
        float x3 = bf2f(axt_[(tg * 16 + 0) * 64 + c]), x2 = bf2f(axt_[(tg * 16 + 1) * 64 + c]), x1 = bf2f(axt_[(tg * 16 + 2) * 64 + c]); \
        _Pragma("unroll") for (int i = 0; i < 16; ++i) { const float x0 = bf2f(axt_[(tg * 16 + i + 3) * 64 + c]); \
            xcb_[(tg * 16 + i) * 72 + c] = f2bf(w0 * x3 + w1 * x2 + w2 * x1 + w3 * x0 + cbias); x3 = x2; x2 = x1; x1 = x0; } } while (0)
#define LRU_GEMM(CK) do { const LAS bf16* xcb_ = XCB + ((CK) & 1) * (128 * 72); LAS bf16* gp_ = GP + (((CK) & 1) * 2 + gsel) * (128 * 32); \
        f32x16 acc; _Pragma("unroll") for (int r = 0; r < 16; ++r) acc[r] = 0.f; \
        _Pragma("unroll") for (int ks = 0; ks < 4; ++ks) { const bf16x8 a = *(const LAS bf16x8*)(xcb_ + (tb * 32 + r32) * 72 + ks * 16 + hi * 8); acc = MFMA32(a, wf[ks], acc); } \
        _Pragma("unroll") for (int r = 0; r < 16; ++r) gp_[(tb * 32 + crow(r, hi)) * 32 + r32] = f2bf(acc[r]); } while (0)
    LRU_PREFETCH(0);
    if (tid < 64) CAR[tid] = 0.f;
    __syncthreads();
    LRU_STORE(0); LRU_PREFETCH(1);
    __syncthreads();
    LRU_CONV(0); LRU_STORE(1); LRU_PREFETCH(2);
    __syncthreads();
    LRU_GEMM(0);
    __syncthreads();
    for (int ck = 0; ck < 16; ++ck) {
        const int t0 = ck * 128;
        if (ck + 1 < 16) LRU_CONV(ck + 1);
        float hl[8], pl[8];
        {
            const LAS bf16* gp_ = GP + (ck & 1) * 2 * (128 * 32); const LAS bf16* xcb_ = XCB + (ck & 1) * (128 * 72);
            float P = 1.f, hh = 0.f;
#pragma unroll
            for (int i = 0; i < 8; ++i) {
                const int tok = tgp * 8 + i;
                const float rg = sigmoidf_(bf2f(gp_[tok * 32 + j]) + ba_), ig = sigmoidf_(bf2f(gp_[(128 + tok) * 32 + j]) + bx_);
                const float a = __expf(rg * sp8);
                float mult = __builtin_amdgcn_sqrtf(fmaxf(1.0f - a * a, 0.f));
                if (t0 + tok == 0) mult = 1.0f;
                hh = a * hh + mult * ig * bf2f(xcb_[tok * 72 + cb * 32 + j]); P *= a;
                hl[i] = hh; pl[i] = P;
            }
            TOT[(tgp * 32 + j) * 2] = P; TOT[(tgp * 32 + j) * 2 + 1] = hh;
        }
        if (ck + 2 < 16) { LRU_STORE(ck + 2); LRU_PREFETCH(ck + 3); }
        lds_barrier();
        if (ck + 1 < 16) LRU_GEMM(ck + 1);
        {
            float hc = CAR[(ck & 1) * 32 + j];
            {
                typedef float f32x2_t __attribute__((ext_vector_type(2)));
                f32x2_t tt[15];
#pragma unroll
                for (int sidx = 0; sidx < 15; ++sidx) tt[sidx] = *(const LAS f32x2_t*)(TOT + (sidx * 32 + j) * 2);
#pragma unroll
                for (int sidx = 0; sidx < 15; ++sidx) { const bool on = sidx < tgp; hc = (on ? tt[sidx].x : 1.f) * hc + (on ? tt[sidx].y : 0.f); }
            }
            const LAS bf16* agt = AGT + (ck % 3) * (128 * 32);
            bf16* yp = Y + (size_t)(b * SEQ + t0 + tgp * 8) * DM + h * 64 + cb * 32 + j;
#pragma unroll
            for (int i = 0; i < 8; ++i) { const float hf = hl[i] + pl[i] * hc; yp[(size_t)i * DM] = f2bf(hf * gelu_tanh(bf2f(agt[(tgp * 8 + i) * 32 + j])));
                if (i == 7 && tgp == 15) CAR[((ck + 1) & 1) * 32 + j] = hf; }
        }
        lds_barrier();
    }
#undef LRU_PREFETCH
#undef LRU_STORE
#undef LRU_CONV
#undef LRU_GEMM
}

DI void cmp_item(Frame& F, int item) {
    const int kv = item >> 7, rest = item & 127, b = rest >> 3, g = (rest >> 2) & 1, cc = rest & 3;
    const int tid = opaque(F.tid), lane = tid & 63, w = F.wave, r32 = lane & 31, hi = lane >> 5;
    const bf16* P1 = (const bf16*)(F.ws + WS_BIG);
    const bf16* W1T = (const bf16*)(F.ws + (kv ? WS_CW1V : WS_CW1K)); const bf16* W2T = (const bf16*)(F.ws + (kv ? WS_CW2V : WS_CW2K));
    const float* CB1 = (const float*)(F.ws + WS_CB1) + kv * 128;
    bf16* OUT = (bf16*)(F.ws + (kv ? WS_VC : WS_KC));
    constexpr int KP = 272;
    LAS unsigned char* AT = F.lds;
    LAS unsigned char* BT = F.lds + 2 * 32 * KP;
    LAS float* RED = (LAS float*)(F.lds + 2 * 32 * KP + 2 * 128 * KP);
    LAS bf16* HD = (LAS bf16*)(F.lds + 2 * 32 * KP + 2 * 128 * KP + 16384);
    const int nb = w & 3, kq = w >> 2;
    const int lc = tid >> 4, lch = tid & 15;
    const int cg = cc * 32 + lc, cgl = cg < 126 ? cg : 126;
    const bf16* asrc = P1 + (size_t)(b * SEQ + 16 * cgl + (lch >> 3)) * IN0P + (kv ? C_VC : C_KC) + g * 64 + (lch & 7) * 8;
    const bf16* bsrc = W1T + (size_t)lc * 2048 + lch * 8;
    const int lofs = lc * KP + lch * 16;
    u32x4 pa, pb[4];
#define CM_LD(T) do { const int t_ = (T) < 16 ? (T) : 15; pa = *(const u32x4*)(asrc + (size_t)(2 * t_) * IN0P); \
        _Pragma("unroll") for (int i = 0; i < 4; ++i) pb[i] = *(const u32x4*)(bsrc + (size_t)(32 * i) * 2048 + 128 * t_); } while (0)
#define CM_ST(BUF) do { *(LAS u32x4*)(AT + (BUF) * 32 * KP + lofs) = pa; \
        _Pragma("unroll") for (int i = 0; i < 4; ++i) *(LAS u32x4*)(BT + (BUF) * 128 * KP + i * 32 * KP + lofs) = pb[i]; } while (0)
    CM_LD(0);
    __syncthreads();
    CM_ST(0);
    __syncthreads();
    f32x16 acc;
#pragma unroll
    for (int r = 0; r < 16; ++r) acc[r] = 0.f;
    for (int t = 0; t < 16; ++t) {
        const int buf = t & 1;
        CM_LD(t + 1);
#pragma unroll
        for (int ks = 0; ks < 4; ++ks) {
            const int kofs = ((kq * 4 + ks) * 16 + hi * 8) * 2;
            const bf16x8 a = *(const LAS bf16x8*)(AT + buf * 32 * KP + r32 * KP + kofs);
            const bf16x8 bw = *(const LAS bf16x8*)(BT + buf * 128 * KP + (nb * 32 + r32) * KP + kofs);
            acc = MFMA32(a, bw, acc);
        }
        CM_ST(buf ^ 1);
        lds_barrier();
    }
#undef CM_LD
#undef CM_ST
    if (kq == 1) {
#pragma unroll
        for (int r = 0; r < 16; ++r) RED[(nb * 16 + r) * 64 + lane] = acc[r];
    }
    __syncthreads();
    if (kq == 0) {
        const int n = nb * 32 + r32; const float bias = CB1[n];
#pragma unroll
        for (int r = 0; r < 16; ++r) { const float v = acc[r] + RED[(nb * 16 + r) * 64 + lane] + bias; HD[crow(r, hi) * 136 + n] = f2bf(gelu_tanh(v)); }
    }
    __syncthreads();
    if (w < 2) {
        f32x16 a2;
#pragma unroll
        for (int r = 0; r < 16; ++r) a2[r] = 0.f;
#pragma unroll
        for (int ks = 0; ks < 8; ++ks) {
            const bf16x8 a = *(const LAS bf16x8*)(HD + r32 * 136 + ks * 16 + hi * 8);
            const bf16x8 bw = *(const bf16x8*)(W2T + (size_t)(w * 32 + r32) * 128 + ks * 16 + hi * 8);
            a2 = MFMA32(a, bw, a2);
        }
        const int d = w * 32 + r32;
#pragma unroll
        for (int r = 0; r < 16; ++r) { const int co = cc * 32 + crow(r, hi); OUT[((size_t)(b * 2 + g) * 128 + co) * 64 + d] = (co < 127) ? f2bf(a2[r]) : (bf16)0; }
    }
    __syncthreads();
}

constexpr int TP = 144;
struct AttnState { f32x16 o0, o1, negm, o2; float mref, l; };
constexpr float ATT_THR = 8.0f;
DI void attn_init(AttnState& st) {
#pragma unroll
    for (int r = 0; r < 16; ++r) { st.o0[r] = 0.f; st.o1[r] = 0.f; st.negm[r] = 0.f; st.o2[r] = 0.f; }
    st.mref = 0.f; st.l = 0.f;
}
DI void load_tile(const bf16* g, size_t pitch, LAS unsigned char* dst, int tid) {
    const int key = tid >> 3, ch = tid & 7;
    const u32x4 v = *(const u32x4*)(g + (size_t)key * pitch + ch * 8);
    *(LAS u32x4*)(dst + key * TP + ch * 16) = v;
}
DI f32x16 qk_block(const LAS unsigned char* Kt, int kb, const bf16x8 (&qf)[4], const f32x16& c0, int r32, int hi) {
    f32x16 s;
#pragma unroll
    for (int ks = 0; ks < 4; ++ks) {
        const bf16x8 kf = *(const LAS bf16x8*)(Kt + (kb * 32 + r32) * TP + (ks * 16 + hi * 8) * 2);
        s = (ks == 0) ? MFMA32(kf, qf[0], c0) : MFMA32(kf, qf[ks], s);
    }
    return s;
}
DI void pv_block(const LAS unsigned char* Vt, int kb, const f32x16& p, f32x16& o0, f32x16& o1, int lane) {
    const int hi = lane >> 5, i16 = lane & 15, q = i16 >> 2, pp = i16 & 3, blk = (lane >> 4) & 1;
#pragma unroll
    for (int s2 = 0; s2 < 2; ++s2) {
        u32x4 pw; pw.x = pk2(p[8 * s2 + 0], p[8 * s2 + 1]); pw.y = pk2(p[8 * s2 + 2], p[8 * s2 + 3]); pw.z = pk2(p[8 * s2 + 4], p[8 * s2 + 5]); pw.w = pk2(p[8 * s2 + 6], p[8 * s2 + 7]);
        const bf16x8 pf = __builtin_bit_cast(bf16x8, pw);
        const int rlo = kb * 32 + 16 * s2 + 4 * hi + q, rhi = rlo + 8;
#pragma unroll
        for (int db = 0; db < 2; ++db) {
            const int cbyte = (32 * db + 16 * blk + 4 * pp) * 2;
            const s16x4 lo = vtr((const LAS char*)(Vt + rlo * TP + cbyte));
            const s16x4 hv = vtr((const LAS char*)(Vt + rhi * TP + cbyte));
            const bf16x8 vf = (bf16x8){lo[0], lo[1], lo[2], lo[3], hv[0], hv[1], hv[2], hv[3]};
            if (db == 0) o0 = MFMA32(vf, pf, o0); else o1 = MFMA32(vf, pf, o1);
        }
    }
}
DI void v_frags(const LAS unsigned char* Vt, bf16x8 (&vf)[8], int lane) {
    const int hi = lane >> 5, i16 = lane & 15, q = i16 >> 2, pp = i16 & 3, blk = (lane >> 4) & 1;
#pragma unroll
    for (int kb = 0; kb < 2; ++kb)
#pragma unroll
        for (int s2 = 0; s2 < 2; ++s2) {
            const int rlo = kb * 32 + 16 * s2 + 4 * hi + q, rhi = rlo + 8;
#pragma unroll
            for (int db = 0; db < 2; ++db) {
                const int cbyte = (32 * db + 16 * blk + 4 * pp) * 2;
                const s16x4 lo = vtr((const LAS char*)(Vt + rlo * TP + cbyte));
                const s16x4 hv = vtr((const LAS char*)(Vt + rhi * TP + cbyte));
                vf[(kb * 2 + s2) * 2 + db] = (bf16x8){lo[0], lo[1], lo[2], lo[3], hv[0], hv[1], hv[2], hv[3]};
            }
        }
}
DI void pv_frags(const bf16x8 (&vf)[8], const f32x16 (&p)[2], f32x16& o0, f32x16& o1) {
#pragma unroll
    for (int kb = 0; kb < 2; ++kb)
#pragma unroll
        for (int s2 = 0; s2 < 2; ++s2) {
            u32x4 pw; pw.x = pk2(p[kb][8 * s2 + 0], p[kb][8 * s2 + 1]); pw.y = pk2(p[kb][8 * s2 + 2], p[kb][8 * s2 + 3]); pw.z = pk2(p[kb][8 * s2 + 4], p[kb][8 * s2 + 5]); pw.w = pk2(p[kb][8 * s2 + 6], p[kb][8 * s2 + 7]);
            const bf16x8 pf = __builtin_bit_cast(bf16x8, pw);
            o0 = MFMA32(vf[(kb * 2 + s2) * 2 + 0], pf, o0); o1 = MFMA32(vf[(kb * 2 + s2) * 2 + 1], pf, o1);
        }
}
DI void pv_frags_sum(const bf16x8 (&vf)[8], const f32x16 (&p)[2], f32x16& o0, f32x16& o1, f32x16& o2, int lane) {
    const short one = (lane & 31) == 0 ? (short)0x3f80 : (short)0;
    const bf16x8 vones = (bf16x8){one, one, one, one, one, one, one, one};
#pragma unroll
    for (int kb = 0; kb < 2; ++kb)
#pragma unroll
        for (int s2 = 0; s2 < 2; ++s2) {
            u32x4 pw; pw.x = pk2(p[kb][8 * s2 + 0], p[kb][8 * s2 + 1]); pw.y = pk2(p[kb][8 * s2 + 2], p[kb][8 * s2 + 3]); pw.z = pk2(p[kb][8 * s2 + 4], p[kb][8 * s2 + 5]); pw.w = pk2(p[kb][8 * s2 + 6], p[kb][8 * s2 + 7]);
            const bf16x8 pf = __builtin_bit_cast(bf16x8, pw);
            o0 = MFMA32(vf[(kb * 2 + s2) * 2 + 0], pf, o0); o1 = MFMA32(vf[(kb * 2 + s2) * 2 + 1], pf, o1); o2 = MFMA32(vones, pf, o2);
        }
}
template <int MODE, class MaskF>
DI void attn_softmax_pv(f32x16 (&s)[2], const bf16x8 (&vf)[8], AttnState& st, const MaskF& mask, int lane) {
    const int hi = lane >> 5;
    float mx = -INFINITY;
#pragma unroll
    for (int kb = 0; kb < 2; ++kb)
#pragma unroll
        for (int r = 0; r < 16; ++r) { float v = s[kb][r]; if (MODE == 1) { if (!mask(kb, r)) v = -INFINITY; s[kb][r] = v; } mx = fmaxf(mx, v); }
    mx = max_x32(mx);
    if (__any(mx > ATT_THR)) {
        const float dl = fmaxf(mx, 0.f), f = __builtin_amdgcn_exp2f(-dl);
        st.mref += dl; st.l *= f;
#pragma unroll
        for (int r = 0; r < 16; ++r) { s[0][r] -= dl; s[1][r] -= dl; st.o0[r] *= f; st.o1[r] *= f; st.negm[r] = -st.mref; }
        if (MODE == 2) st.o2[0] *= f;
    }
    float ls = 0.f;
#pragma unroll
    for (int kb = 0; kb < 2; ++kb)
#pragma unroll
        for (int r = 0; r < 16; ++r) { float p = __builtin_amdgcn_exp2f(s[kb][r]); if (MODE == 2) p = __int_as_float(__float_as_int(p) & mask.bits(kb, r)); s[kb][r] = p; if (MODE != 2) ls += p; }
    st.l += ls;
    __builtin_amdgcn_sched_barrier(0);
    if (MODE == 2) pv_frags_sum(vf, s, st.o0, st.o1, st.o2, lane); else pv_frags(vf, s, st.o0, st.o1);
}
DI bf16x8 scale_frag(bf16x8 q, float c) {
    u32x4 u = __builtin_bit_cast(u32x4, q), o;
#pragma unroll
    for (int e = 0; e < 4; ++e) { const float lo = __uint_as_float(u[e] << 16) * c, hv = __uint_as_float(u[e] & 0xffff0000u) * c; o[e] = pk2(lo, hv); }
    return __builtin_bit_cast(bf16x8, o);
}
DI void attn_fold(const AttnState& st, float gate, f32x16& f0, f32x16& f1) {
    const float lt = sum_x32(st.l);
    const float sc = lt > 0.f ? gate / lt : 0.f;
#pragma unroll
    for (int r = 0; r < 16; ++r) { f0[r] += sc * st.o0[r]; f1[r] += sc * st.o1[r]; }
}
DI void attn_fold_lds(const AttnState& st, float gate, LAS float* fst) {
    const float lt = sum_x32(st.l);
    const float sc = lt > 0.f ? gate / lt : 0.f;
#pragma unroll
    for (int r = 0; r < 16; ++r) { fst[r * 64] += sc * st.o0[r]; fst[(16 + r) * 64] += sc * st.o1[r]; }
}
DI void store_rowT(bf16* dst, const f32x16& f0, const f32x16& f1, int hi) {
#pragma unroll
    for (int rr = 0; rr < 4; ++rr) {
        u32x2 w0; w0.x = pk2(f0[4 * rr], f0[4 * rr + 1]); w0.y = pk2(f0[4 * rr + 2], f0[4 * rr + 3]);
        u32x2 w1; w1.x = pk2(f1[4 * rr], f1[4 * rr + 1]); w1.y = pk2(f1[4 * rr + 2], f1[4 * rr + 3]);
        *(u32x2*)(dst + 8 * rr + 4 * hi) = w0; *(u32x2*)(dst + 32 + 8 * rr + 4 * hi) = w1;
    }
}
template <class RowPtr>
DI void store_rows_staged(LAS unsigned char* stage, const f32x16& f0, const f32x16& f1, int lane, RowPtr rowptr) {
    const int r32 = lane & 31, hi = lane >> 5;
#pragma unroll
    for (int rr = 0; rr < 4; ++rr) {
        u32x2 w0; w0.x = pk2(f0[4 * rr], f0[4 * rr + 1]); w0.y = pk2(f0[4 * rr + 2], f0[4 * rr + 3]);
        u32x2 w1; w1.x = pk2(f1[4 * rr], f1[4 * rr + 1]); w1.y = pk2(f1[4 * rr + 2], f1[4 * rr + 3]);
        *(LAS u32x2*)(stage + r32 * TP + (8 * rr + 4 * hi) * 2) = w0; *(LAS u32x2*)(stage + r32 * TP + (32 + 8 * rr + 4 * hi) * 2) = w1;
    }
    asm volatile("s_waitcnt lgkmcnt(0)" ::: "memory");
#pragma unroll
    for (int i = 0; i < 4; ++i) { const int ri = (lane >> 3) + 8 * i, ch = lane & 7; const u32x4 v = *(const LAS u32x4*)(stage + ri * TP + ch * 16); *(u32x4*)(rowptr(ri) + ch * 8) = v; }
    asm volatile("s_waitcnt lgkmcnt(0)" ::: "memory");
}

template <class M>
DI void attn_step_simple(LAS unsigned char* buf, int cur, int j, const bf16x8 (&qf)[4], AttnState& st, M& mask, int lane) {
    const int r32 = lane & 31, hi = lane >> 5;
    f32x16 sc[2];
    sc[0] = qk_block(buf + cur, 0, qf, st.negm, r32, hi); sc[1] = qk_block(buf + cur, 1, qf, st.negm, r32, hi);
    mask.begin(j);
    bf16x8 vf[8];
    v_frags(buf + cur + 9216, vf, lane);
    if (mask.full()) attn_softmax_pv<0>(sc, vf, st, mask, lane);
    else attn_softmax_pv<M::MODE>(sc, vf, st, mask, lane);
}
template <bool BATCHV, class M>
DI void attn_step(LAS unsigned char* buf, int cur, int j, const bf16x8 (&qf)[4], AttnState& st, M& mask, int lane) {
    const int r32 = lane & 31, hi = lane >> 5;
    bf16x8 kf[2][4];
#pragma unroll
    for (int kb = 0; kb < 2; ++kb)
#pragma unroll
        for (int ks = 0; ks < 4; ++ks) kf[kb][ks] = *(const LAS bf16x8*)(buf + cur + (kb * 32 + r32) * TP + (ks * 16 + hi * 8) * 2);
    mask.begin(j);
    __builtin_amdgcn_sched_barrier(0);
    f32x16 sc[2];
#pragma unroll
    for (int kb = 0; kb < 2; ++kb)
#pragma unroll
        for (int ks = 0; ks < 4; ++ks) sc[kb] = (ks == 0) ? MFMA32(kf[kb][0], qf[0], st.negm) : MFMA32(kf[kb][ks], qf[ks], sc[kb]);
    bf16x8 vf[8];
    v_frags(buf + cur + 9216, vf, lane);
    if (BATCHV) __builtin_amdgcn_sched_barrier(0);
#if defined(X_VALU)
    {
        f32x16 e0 = sc[0], e1 = sc[1];
#pragma unroll
#if X_VALU == 2
        for (int r = 0; r < 16; ++r) { e0[r] = (e0[r] - 40.f) * e1[r] + 3.f; e1[r] = (e1[r] - 40.f) * e0[r] + 5.f; e0[r] = e0[r] * e1[r] + 1.f; e1[r] = e1[r] * 0.5f + e0[r]; }
#else
        for (int r = 0; r < 16; ++r) { e0[r] = __builtin_amdgcn_exp2f(e0[r] - 40.f); e1[r] = __builtin_amdgcn_exp2f(e1[r] - 40.f); }
#endif
        float acc = 0.f;
#pragma unroll
        for (int r = 0; r < 16; ++r) acc += e0[r] + e1[r];
        asm volatile("" :: "v"(acc));
    }
#endif
    if (mask.full()) attn_softmax_pv<0>(sc, vf, st, mask, lane);
    else attn_softmax_pv<M::MODE>(sc, vf, st, mask, lane);
}
template <bool PRE, class M>
DI void attn_stream1(LAS unsigned char* buf, const bf16* kv0, int voff, size_t pitch, int j0, int j1, const bf16x8 (&qf)[4], AttnState& st, M& mask, int tid, int lane) {
    const int key = tid >> 3, ch = tid & 7;
    const bf16* gp = kv0 + (size_t)key * pitch + ch * 8;
    const int lo = key * TP + ch * 16;
    u32x4 rk, rv;
    if (!PRE) {
        rk = *(const u32x4*)(gp + (size_t)j0 * 64 * pitch); rv = *(const u32x4*)(gp + (size_t)j0 * 64 * pitch + voff);
        __syncthreads();
        *(LAS u32x4*)(buf + lo) = rk; *(LAS u32x4*)(buf + 9216 + lo) = rv;
        __syncthreads();
    }
    for (int j = j0; j <= j1; ++j) {
        const int cur = ((j - j0) & 1) * 18432;
        const int jp = j < j1 ? j + 1 : j1;
        rk = *(const u32x4*)(gp + (size_t)jp * 64 * pitch); rv = *(const u32x4*)(gp + (size_t)jp * 64 * pitch + voff);
        attn_step<false>(buf, cur, j, qf, st, mask, lane);
        *(LAS u32x4*)(buf + (cur ^ 18432) + lo) = rk; *(LAS u32x4*)(buf + (cur ^ 18432) + 9216 + lo) = rv;
        lds_barrier();
    }
}
template <class M, class Pre>
DI void attn_stream(LAS unsigned char* buf, const bf16* kv0, const bf16* nkv0, int voff, size_t pitch, int j0, int j1, const bf16x8 (&qf)[4], AttnState& st, M& mask, int tid, int lane,
                    u32x4& ka, u32x4& va, u32x4& kb_, u32x4& vb_, Pre pre  ) {
    const int key = tid >> 3, ch = tid & 7;
    const bf16* gp = kv0 + (size_t)key * pitch + ch * 8;
    const bf16* ngp = nkv0 + (size_t)key * pitch + ch * 8;
    const int lo = key * TP + ch * 16;
#define AS_LD(RK, RV, J) do { const bool in_ = (J) <= j1; const bf16* p_ = (in_ ? gp : ngp) + (size_t)(in_ ? (J) : (J) - j1 - 1) * 64 * pitch; RK = *(const u32x4*)(p_); RV = *(const u32x4*)(p_ + voff); } while (0)
#define AS_ST(SLOT, RK, RV) do { *(LAS u32x4*)(buf + (SLOT) + lo) = RK; *(LAS u32x4*)(buf + (SLOT) + 9216 + lo) = RV; } while (0)
    __syncthreads();
    pre();
    AS_ST(0, ka, va);
    __syncthreads();
    for (int j = j0; j <= j1; j += 2) {
        AS_LD(ka, va, j + 2);
        attn_step<true>(buf, 0, j, qf, st, mask, lane);
        AS_ST(18432, kb_, vb_);
        lds_barrier();
        if (j + 1 > j1) break;
        AS_LD(kb_, vb_, j + 3);
        attn_step<true>(buf, 18432, j + 1, qf, st, mask, lane);
        AS_ST(0, ka, va);
        lds_barrier();
    }
#undef AS_LD
#undef AS_ST
}
struct MaskSlc { static constexpr int MODE = 1; DI int bits(int, int) const { return -1; } unsigned sel; int t4, qb; bool rs, fl; int lim;
    DI void begin(int j) { rs = (sel >> j) & 1u; lim = rs ? t4 - j * 64 : -1; fl = (j < qb) && __all(rs); }
    DI bool full() const { return fl; }
    DI bool operator()(int kb, int r) const { return (32 * kb + (r & 3) + 8 * (r >> 2)) <= lim; } };
struct MaskWin { static constexpr int MODE = 1; DI int bits(int, int) const { return -1; } int t4, qb; int lim; bool fl;
    DI void begin(int j) { lim = t4 - j * 64; fl = (j < qb) && (j >= qb - 7); }
    DI bool full() const { return fl; }
    DI bool operator()(int kb, int r) const { const int c = 32 * kb + (r & 3) + 8 * (r >> 2); return c <= lim && c > lim - 512; } };
struct MaskBits { static constexpr int MODE = 2; const LAS unsigned* row; int sh; unsigned w0, w1;
    DI void begin(int j) { w0 = row[2 * j] >> sh; w1 = row[2 * j + 1] >> sh; }
    DI bool full() const { return false; }
    DI bool operator()(int, int) const { return true; }
    DI int bits(int kb, int r) const { int m; asm("v_bfe_i32 %0, %1, %2, 1" : "=v"(m) : "v"(kb ? w1 : w0), "n"((r & 3) + 8 * (r >> 2))); return m; } };

DI void nsa_item(Frame& F, int it) {
    const int bg = it & 31, u = it >> 5, rq = u >> 3, sq = u & 7;
    const int qb = rq == 0 ? sq : rq == 1 ? 15 - sq : rq == 2 ? 16 + sq : 31 - sq;
    const int b = bg >> 1, g = bg & 1;
    const int tid = opaque(F.tid), lane = tid & 63, w = F.wave, r32 = lane & 31, hi = lane >> 5;
    LAS unsigned char* KT0 = F.lds; LAS unsigned char* VT0 = F.lds + 9216; LAS unsigned char* KT1 = F.lds + 18432; LAS unsigned char* VT1 = F.lds + 27648;
    LAS float* PS = (LAS float*)(F.lds + 36864) + w * 1024;
    LAS unsigned* SELM = (LAS unsigned*)(F.lds + 69632);
    LAS float* FST = (LAS float*)(F.lds + 70144) + w * 2176 + lane;
    const bf16* P1 = (const bf16*)(F.ws + WS_BIG);
    const int t = qb * 64 + w * 8 + (r32 >> 2), hd = r32 & 3, head = g * 4 + hd;
    const bf16* rowp = P1 + (size_t)(b * SEQ + t) * IN0P;
    bf16x8 qf[4];
#pragma unroll
    for (int ks = 0; ks < 4; ++ks) qf[ks] = *(const bf16x8*)(rowp + C_Q + head * 64 + ks * 16 + hi * 8);
    const bf16 gr0 = rowp[C_GT + head * 3 + 0], gr1 = rowp[C_GT + head * 3 + 1], gr2 = rowp[C_GT + head * 3 + 2];
    const int ntc = (qb <= 15) ? 1 : 2, jw0 = (qb >= 8 ? qb - 8 : 0);
    const int lkey = tid >> 3, lch = tid & 7, llo = lkey * TP + lch * 16;
    u32x4 ck0, cv0, ck1, cv1, sk0, sv0, wk0, wv0;
    {
        const bf16* KC = (const bf16*)(F.ws + WS_KC) + (size_t)bg * 128 * 64 + (size_t)lkey * 64 + lch * 8; const bf16* VC = (const bf16*)(F.ws + WS_VC) + (size_t)bg * 128 * 64 + (size_t)lkey * 64 + lch * 8;
        ck0 = *(const u32x4*)KC; cv0 = *(const u32x4*)VC;
        ck1 = *(const u32x4*)(KC + (ntc == 2 ? 64 * 64 : 0)); cv1 = *(const u32x4*)(VC + (ntc == 2 ? 64 * 64 : 0));
        const bf16* sp = P1 + (size_t)(b * SEQ + lkey) * IN0P + C_KS + g * 64 + lch * 8;
        sk0 = *(const u32x4*)sp; sv0 = *(const u32x4*)(sp + (C_VS - C_KS));
        const bf16* wp = P1 + (size_t)(b * SEQ + jw0 * 64 + lkey) * IN0P + C_KW + g * 64 + lch * 8;
        wk0 = *(const u32x4*)wp; wv0 = *(const u32x4*)(wp + (C_VW - C_KW));
    }
    const float g0 = sigmoidf_(bf2f(gr0));
    FST[32 * 64] = sigmoidf_(bf2f(gr1)); FST[33 * 64] = sigmoidf_(bf2f(gr2));
#pragma unroll
    for (int ks = 0; ks < 4; ++ks) qf[ks] = scale_frag(qf[ks], 0.125f * 1.4426950408889634f);
    f32x16 f0, f1;
#pragma unroll
    for (int r = 0; r < 16; ++r) { f0[r] = 0.f; f1[r] = 0.f; }
    {
        __syncthreads();
        *(LAS u32x4*)(KT0 + llo) = ck0; *(LAS u32x4*)(VT0 + llo) = cv0;
        if (ntc == 2) { *(LAS u32x4*)(KT1 + llo) = ck1; *(LAS u32x4*)(VT1 + llo) = cv1; }
        __syncthreads();
        float mx = -INFINITY;
#pragma unroll
        for (int blk = 0; blk < 4; ++blk) {
            if ((blk >> 1) < ntc) {
                const f32x16 sb = qk_block((blk >> 1) ? KT1 : KT0, blk & 1, qf, f0, r32, hi);
#pragma unroll
                for (int r = 0; r < 16; ++r) { const int c = blk * 32 + crow(r, hi); if (16 * c + 31 <= t) mx = fmaxf(mx, sb[r]); }
            }
        }
        mx = max_x32(mx);
        const float mu = (mx == -INFINITY) ? 0.f : mx;
        float ls = 0.f;
#pragma unroll
        for (int blk = 0; blk < 4; ++blk) {
            if ((blk >> 1) < ntc) {
                const f32x16 sb = qk_block((blk >> 1) ? KT1 : KT0, blk & 1, qf, f0, r32, hi);
#pragma unroll
                for (int r = 0; r < 16; ++r) { const int c = blk * 32 + crow(r, hi); if (16 * c + 31 <= t) ls += __builtin_amdgcn_exp2f(sb[r] - mu); }
            }
        }
        ls = sum_x32(ls);
        const float inv = ls > 0.f ? __builtin_amdgcn_rcpf(ls) : 0.f;
        f32x16 o0, o1;
#pragma unroll
        for (int r = 0; r < 16; ++r) { o0[r] = 0.f; o1[r] = 0.f; }
#pragma unroll
        for (int blk = 0; blk < 4; ++blk) {
            f32x16 p;
            if ((blk >> 1) < ntc) {
                p = qk_block((blk >> 1) ? KT1 : KT0, blk & 1, qf, f0, r32, hi);
#pragma unroll
                for (int r = 0; r < 16; ++r) { const int c = blk * 32 + crow(r, hi); p[r] = (16 * c + 31 <= t) ? __builtin_amdgcn_exp2f(p[r] - mu) * inv : 0.f; }
                pv_block((blk >> 1) ? VT1 : VT0, blk & 1, p, o0, o1, lane);
            } else {
#pragma unroll
                for (int r = 0; r < 16; ++r) p[r] = 0.f;
            }
#pragma unroll
            for (int r = 0; r < 16; ++r) { float v = p[r]; v += dppf(v, DPP_XOR1); v += dppf(v, DPP_XOR2); if (hd == 0) PS[(r32 >> 2) * 128 + blk * 32 + crow(r, hi)] = v; }
        }
#pragma unroll
        for (int r = 0; r < 16; ++r) { FST[r * 64] = o0[r] * g0; FST[(16 + r) * 64] = o1[r] * g0; }
        __syncthreads();
        {
            const int tok8 = lane >> 3, jq = lane & 7;
            float imp[4];
#pragma unroll
            for (int e = 0; e < 4; ++e) {
                const int j = 4 * jq + e; float v = 0.f;
#pragma unroll
                for (int dc = -1; dc <= 3; ++dc) { const int c = 4 * j + dc; if (c >= 0) v += PS[tok8 * 128 + c]; }
                if (j == 0 || j == qb || j == qb - 1) v = 1e4f;
                if (j > qb) v = -INFINITY;
                imp[e] = v;
            }
            unsigned sel = 0u;
            for (int itr = 0; itr < 8; ++itr) {
                float bv = imp[0]; int bj = 4 * jq;
#pragma unroll
                for (int e = 1; e < 4; ++e) if (imp[e] > bv) { bv = imp[e]; bj = 4 * jq + e; }
#pragma unroll
#define TOP_STEP(CTL) do { const float ov = dppf(bv, CTL); const int oj = __builtin_amdgcn_update_dpp(0, bj, CTL, 0xf, 0xf, true); if (ov > bv || (ov == bv && oj < bj)) { bv = ov; bj = oj; } } while (0)
                TOP_STEP(DPP_XOR1); TOP_STEP(DPP_XOR2); TOP_STEP(DPP_HMIR);
#undef TOP_STEP
                sel |= 1u << bj;
#pragma unroll
                for (int e = 0; e < 4; ++e) if (4 * jq + e == bj) imp[e] = -INFINITY;
            }
            if (jq == 0) SELM[w * 8 + tok8] = sel;
        }
        __syncthreads();
    }
    const unsigned mysel = SELM[w * 8 + (r32 >> 2)];
    LAS unsigned char* PSW = F.lds + 36864;
    *(LAS u32x4*)(F.lds + llo) = sk0; *(LAS u32x4*)(F.lds + 9216 + llo) = sv0;
    *(LAS u32x4*)(PSW + llo) = wk0; *(LAS u32x4*)(PSW + 9216 + llo) = wv0;
    __syncthreads();
    {
        AttnState st; attn_init(st);
        MaskSlc mk; mk.sel = mysel; mk.t4 = t - 4 * hi; mk.qb = qb;
        attn_stream1<true>(F.lds, P1 + (size_t)(b * SEQ) * IN0P + C_KS + g * 64, C_VS - C_KS, IN0P, 0, qb, qf, st, mk, tid, lane);
        attn_fold_lds(st, FST[32 * 64], FST);
    }
    {
        {
            const u32x4 tk = *(const LAS u32x4*)(PSW + llo), tv = *(const LAS u32x4*)(PSW + 9216 + llo);
            *(LAS u32x4*)(F.lds + llo) = tk; *(LAS u32x4*)(F.lds + 9216 + llo) = tv;
            lds_barrier();
        }
        AttnState st; attn_init(st);
        MaskWin mk; mk.t4 = t - 4 * hi; mk.qb = qb;
        attn_stream1<true>(F.lds, P1 + (size_t)(b * SEQ) * IN0P + C_KW + g * 64, C_VW - C_KW, IN0P, jw0, qb, qf, st, mk, tid, lane);
        const float lt = sum_x32(st.l), scw = lt > 0.f ? FST[33 * 64] / lt : 0.f;
#pragma unroll
        for (int r = 0; r < 16; ++r) { f0[r] = FST[r * 64] + scw * st.o0[r]; f1[r] = FST[(16 + r) * 64] + scw * st.o1[r]; }
    }
    bf16* Y = (bf16*)(F.ws + WS_Y);
    {
        bf16* ybase = Y + (size_t)(b * SEQ + qb * 64 + w * 8) * DM + 512 + g * 256;
        store_rows_staged(F.lds + w * 4608, f0, f1, lane, [&](int ri) { return ybase + (size_t)(ri >> 2) * DM + (ri & 3) * 64; });
    }
}

DI unsigned f2key(float f) { unsigned u = __float_as_uint(f); if (u == 0x80000000u) u = 0u; return (u & 0x80000000u) ? ~u : (u | 0x80000000u); }
DI float key2f(unsigned k) { return __uint_as_float((k & 0x80000000u) ? (k & 0x7fffffffu) : ~k); }
DI int row_sum16(int v) {
    v += __builtin_amdgcn_update_dpp(0, v, 0xB1, 0xf, 0xf, true);
    v += __builtin_amdgcn_update_dpp(0, v, 0x4E, 0xf, 0xf, true);
    v += __builtin_amdgcn_update_dpp(0, v, 0x141, 0xf, 0xf, true);
    v += __builtin_amdgcn_update_dpp(0, v, 0x140, 0xf, 0xf, true);
    return v;
}
struct IdxPre { bf16x8 af[2]; bf16 w4r[4]; u32x4 rr[4]; };
DI void dsa_index_decode(int it, int& b, int& qt16) { const int u_ = it >> 4, k_ = u_ >> 4, s_ = u_ & 15; b = it & 15; qt16 = (k_ & 1) ? 32 * (k_ >> 1) + 31 - s_ : 32 * (k_ >> 1) + s_; }
DI void dsa_index_front(Frame& F, int it, IdxPre& P) {
    int b, qt16; dsa_index_decode(it, b, qt16);
    const int tid = opaque(F.tid), lane = tid & 63, w = F.wave, hi = lane >> 5, key16 = lane & 15, g4 = lane >> 4;
    const bf16* L1 = (const bf16*)(F.ws + WS_BIG);
    {
        const int row = key16, q = row >> 3, h = row & 7;
        const bf16* qp = L1 + (size_t)(b * SEQ + qt16 * 16 + w * 2 + q) * IN1P + D_QI + h * 64 + g4 * 8;
        P.af[0] = *(const bf16x8*)(qp); P.af[1] = *(const bf16x8*)(qp + 32);
    }
#pragma unroll
    for (int i = 0; i < 4; ++i) P.w4r[i] = L1[(size_t)(b * SEQ + qt16 * 16 + w * 2 + hi) * IN1P + D_WI + 4 * (g4 & 1) + i];
    const bf16* gp = L1 + (size_t)(b * SEQ + (tid >> 3)) * IN1P + D_KI + (tid & 7) * 8;
#pragma unroll
    for (int i = 0; i < 4; ++i) P.rr[i] = *(const u32x4*)(gp + (size_t)(64 * i) * IN1P);
}
DI void dsa_index_item(Frame& F, int it, int itn, IdxPre& P) {
    int b, qt16; dsa_index_decode(it, b, qt16);
    const int tid = opaque(F.tid), lane = tid & 63, w = F.wave, r32 = lane & 31, hi = lane >> 5, key16 = lane & 15, g4 = lane >> 4;
    const bf16* L1 = (const bf16*)(F.ws + WS_BIG);
    LAS unsigned char* ring = F.lds;
    const int tq = qt16 * 16 + w * 2 + hi;
    typedef float f32x4_t __attribute__((ext_vector_type(4)));
    bf16x8 af[2];
    af[0] = P.af[0]; af[1] = P.af[1];
    float w4[4];
#pragma unroll
    for (int i = 0; i < 4; ++i) w4[i] = bf2f(P.w4r[i]) * (0.125f * 0.35355339059327373f);
    const int nslab = (((qt16 * 16 + 15) >> 6) >> 2) + 1;
    float sf[64];
#pragma unroll
    for (int kb = 0; kb < 64; ++kb) sf[kb] = -INFINITY;
    {
        const int key = tid >> 3, ch = tid & 7;
        const bf16* gp = L1 + (size_t)(b * SEQ + key) * IN1P + D_KI + ch * 8;
        const int lo = key * TP + ch * 16;
        u32x4 rr[4];
#pragma unroll
        for (int i = 0; i < 4; ++i) rr[i] = P.rr[i];
#define IX_LD(S) do { _Pragma("unroll") for (int i_ = 0; i_ < 4; ++i_) rr[i_] = *(const u32x4*)(gp + (size_t)((S) * 256 + 64 * i_) * IN1P); } while (0)
#define IX_ST(SLOT) do { _Pragma("unroll") for (int i_ = 0; i_ < 4; ++i_) *(LAS u32x4*)(ring + (SLOT) + i_ * 64 * TP + lo) = rr[i_]; } while (0)
        __syncthreads();
        IX_ST(0);
        __syncthreads();
#pragma unroll
        for (int sl = 0; sl < 8; ++sl) {
            if (sl < nslab) {
                const int cur = (sl & 1) * 36864;
                if (sl + 1 < nslab) IX_LD(sl + 1);
#pragma unroll
                for (int kl = 0; kl < 8; ++kl) {
                    f32x4_t a0 = {0.f, 0.f, 0.f, 0.f}, a1 = {0.f, 0.f, 0.f, 0.f};
#pragma unroll
                    for (int ks2 = 0; ks2 < 2; ++ks2) {
                        const bf16x8 b0 = *(const LAS bf16x8*)(ring + cur + (kl * 32 + key16) * TP + (32 * ks2 + 8 * g4) * 2);
                        const bf16x8 b1 = *(const LAS bf16x8*)(ring + cur + (kl * 32 + 16 + key16) * TP + (32 * ks2 + 8 * g4) * 2);
                        a0 = __builtin_amdgcn_mfma_f32_16x16x32_bf16(af[ks2], b0, a0, 0, 0, 0);
                        a1 = __builtin_amdgcn_mfma_f32_16x16x32_bf16(af[ks2], b1, a1, 0, 0, 0);
                    }
                    float s0 = 0.f, s1 = 0.f;
#pragma unroll
                    for (int i = 0; i < 4; ++i) { s0 += w4[i] * fmaxf(a0[i], 0.f); s1 += w4[i] * fmaxf(a1[i], 0.f); }
                    const bool odd = g4 & 1;
                    const float keep = odd ? s1 : s0, give = odd ? s0 : s1;
                    float full = keep + xor16f(give, odd);
                    if (full == 0.f) full = 0.f;
                    const int kidx = (sl * 8 + kl) * 32 + r32;
                    sf[sl * 8 + kl] = kidx <= tq ? full : -INFINITY;
                }
                if (sl + 1 < nslab) IX_ST(cur ^ 36864);
                lds_barrier();
            }
        }
#undef IX_LD
#undef IX_ST
    }
    dsa_index_front(F, itn, P);
    const int tqb = qt16 * 16 + w * 2;
    const bool fullq0 = tqb < 256, fullq1 = tqb + 1 < 256;
    unsigned tau0 = 0u, tau1 = 0u; bool ex0 = fullq0, ex1 = fullq1;
    const int ngrp = (((tqb + 1) >> 5) + 8) >> 3;
#define IDX_GRP(W, G) if ((G) < ngrp) { _Pragma("unroll") for (int kb = 8 * (G); kb < 8 * (G) + 8; ++kb) W = __builtin_amdgcn_alignbit(W, __float_as_uint(sf[kb] - cf_), 31); }
#define IDX_COUNT_LT(C0, C1, N0, N1) do { const float cf_ = hi ? key2f(C1) : key2f(C0); unsigned wl_ = 0u, wh_ = 0u; \
        IDX_GRP(wl_, 0) IDX_GRP(wl_, 1) IDX_GRP(wl_, 2) IDX_GRP(wl_, 3) IDX_GRP(wh_, 4) IDX_GRP(wh_, 5) IDX_GRP(wh_, 6) IDX_GRP(wh_, 7) \
        const int rs_ = row_sum16(__popc(wl_) + __popc(wh_)); const int skip_ = (8 - ngrp) * 256;     \
        N0 = __builtin_amdgcn_readlane(rs_, 0) + __builtin_amdgcn_readlane(rs_, 16) + skip_; N1 = __builtin_amdgcn_readlane(rs_, 32) + __builtin_amdgcn_readlane(rs_, 48) + skip_; } while (0)
    unsigned lo0 = 0u, lo1 = 0u, hi0, hi1, gs0 = 0u, gs1 = 0u;
    {
        float mxl = -INFINITY;
#pragma unroll
        for (int kb = 0; kb < 64; ++kb) if ((kb >> 3) < ngrp) mxl = fmaxf(mxl, sf[kb]);
        mxl = fmaxf(mxl, dppf(mxl, DPP_XOR1)); mxl = fmaxf(mxl, dppf(mxl, DPP_XOR2)); mxl = fmaxf(mxl, dppf(mxl, DPP_HMIR)); mxl = fmaxf(mxl, dppf(mxl, DPP_MIR));
        const unsigned m0 = f2key(fmaxf(__uint_as_float(__builtin_amdgcn_readlane(__float_as_uint(mxl), 0)), __uint_as_float(__builtin_amdgcn_readlane(__float_as_uint(mxl), 16))));
        const unsigned m1 = f2key(fmaxf(__uint_as_float(__builtin_amdgcn_readlane(__float_as_uint(mxl), 32)), __uint_as_float(__builtin_amdgcn_readlane(__float_as_uint(mxl), 48))));
        hi0 = m0 + 1u; hi1 = m1 + 1u;
        if (m0 > 0x83000000u) gs0 = m0 - (5u << 23);
        if (m1 > 0x83000000u) gs1 = m1 - (5u << 23);
    }
    bool dn0 = fullq0, dn1 = fullq1;
    for (int itn = 0; itn < 40; ++itn) {
        const unsigned c0 = dn0 ? lo0 : (gs0 ? gs0 : lo0 + ((hi0 - lo0) >> 1)), c1 = dn1 ? lo1 : (gs1 ? gs1 : lo1 + ((hi1 - lo1) >> 1));
        gs0 = 0u; gs1 = 0u;
        int l0, l1; IDX_COUNT_LT(c0, c1, l0, l1);
        const int g0 = 2048 - l0, g1 = 2048 - l1;
        if (!dn0) { if (g0 >= 256) { lo0 = c0; if (g0 == 256) { ex0 = true; dn0 = true; } } else hi0 = c0; if (hi0 - lo0 <= 1u) dn0 = true; }
        if (!dn1) { if (g1 >= 256) { lo1 = c1; if (g1 == 256) { ex1 = true; dn1 = true; } } else hi1 = c1; if (hi1 - lo1 <= 1u) dn1 = true; }
        if (dn0 && dn1) break;
    }
    tau0 = lo0; tau1 = lo1;
    const bool anytie = !(ex0 && ex1);
    int need = 0;
    if (anytie) { int l0, l1; IDX_COUNT_LT(tau0 + 1u, tau1 + 1u, l0, l1); need = 256 - (2048 - (hi ? l1 : l0)); }
#undef IDX_COUNT_LT
#undef IDX_GRP
    const float ft = hi ? key2f(tau1) : key2f(tau0);
    const bool exact = hi ? ex1 : ex0, full_q = hi ? fullq1 : fullq0;
    int running = 0; unsigned w0 = 0u, w1 = 0u;
#pragma unroll
    for (int kb = 0; kb < 64; ++kb) {
        if ((kb >> 3) >= ngrp) continue;
        bool sel = sf[kb] >= ft;
        if (anytie) {
            const bool tie = (sf[kb] == ft);
            const unsigned long long bal = __ballot(tie);
            const unsigned hb = hi ? (unsigned)(bal >> 32) : (unsigned)bal;
            const int before = running + __popc(hb & ((1u << r32) - 1u));
            running += __popc(hb);
            if (!exact) sel = (sf[kb] > ft) || (tie && before < need);
        }
        if (full_q) sel = (kb * 32 + r32) <= tq;
        const unsigned long long sb = __ballot(sel);
        const unsigned word = hi ? (unsigned)(sb >> 32) : (unsigned)sb;
        if (r32 == (kb & 31)) { if (kb < 32) w0 = word; else w1 = word; }
    }
    unsigned* MASK = (unsigned*)(F.ws + WS_MASK) + ((size_t)(b * 64 + (qt16 >> 1)) * 32 + (qt16 & 1) * 16 + w * 2 + hi) * 64;
    MASK[r32] = w0; MASK[32 + r32] = w1;
}

struct DsaPre { bf16x8 qf[4]; unsigned mwd[4]; u32x4 ka, va, kb, vb; int odd; };
DI void dsa_attn_decode(int it, int& b, int& g, int& qt) { const int bg = it & 31, u = it >> 5, rq = u >> 3, sq = u & 7; qt = (rq >> 1) * 16 + ((rq & 1) ? 15 - sq : sq); b = bg >> 1; g = bg & 1; }
DI void dsa_attn_front(Frame& F, int it, DsaPre& P) {
    int b, g, qt; dsa_attn_decode(it, b, g, qt);
    const int tid = opaque(F.tid), lane = tid & 63, w = F.wave, r32 = lane & 31, hi = lane >> 5;
    const bf16* L1 = (const bf16*)(F.ws + WS_BIG);
    const unsigned* MASK = (const unsigned*)(F.ws + WS_MASK) + (size_t)(b * 64 + qt) * 32 * 64;
    const bf16* rowp = L1 + (size_t)(b * SEQ + qt * 32 + r32) * IN1P;
#pragma unroll
    for (int ks = 0; ks < 4; ++ks) P.qf[ks] = *(const bf16x8*)(rowp + D_Q + (g * 8 + w) * 64 + ks * 16 + hi * 8);
#pragma unroll
    for (int e = 0; e < 4; ++e) P.mwd[e] = MASK[tid + e * NTHR];
}
DI void dsa_attn_front_kv(Frame& F, int it, DsaPre& P) {
    int b, g, qt; dsa_attn_decode(it, b, g, qt);
    const int tid = opaque(F.tid), key = tid >> 3, ch = tid & 7;
    const bf16* gp = (const bf16*)(F.ws + WS_BIG) + (size_t)(b * SEQ + key) * IN1P + D_K + g * 64 + ch * 8;
    const int t1 = (qt >> 1) >= 1 ? 1 : 0;
    P.ka = *(const u32x4*)gp; P.va = *(const u32x4*)(gp + (D_V - D_K)); P.kb = *(const u32x4*)(gp + (size_t)t1 * 64 * IN1P); P.vb = *(const u32x4*)(gp + (size_t)t1 * 64 * IN1P + (D_V - D_K)); P.odd = 0;
}
DI void dsa_attn_item(Frame& F, int it, int itn, DsaPre& P) {
    int b, g, qt; dsa_attn_decode(it, b, g, qt);
    int nb, ng, nqt; dsa_attn_decode(itn, nb, ng, nqt);
    const int tid = opaque(F.tid), lane = tid & 63, w = F.wave, r32 = lane & 31, hi = lane >> 5;
    const bf16* L1 = (const bf16*)(F.ws + WS_BIG);
    LAS unsigned* MASKL = (LAS unsigned*)(F.lds + 55296);
    const int head = g * 8 + w;
    bf16x8 qf[4];
#pragma unroll
    for (int ks = 0; ks < 4; ++ks) qf[ks] = P.qf[ks];
    unsigned mwd[4];
#pragma unroll
    for (int e = 0; e < 4; ++e) mwd[e] = P.mwd[e];
    if (P.odd) { const u32x4 tk = P.ka, tv = P.va; P.ka = P.kb; P.va = P.vb; P.kb = tk; P.vb = tv; }
    AttnState st; attn_init(st);
    MaskBits mk; mk.row = MASKL + r32 * 65; mk.sh = 4 * hi;
    attn_stream(F.lds, L1 + (size_t)(b * SEQ) * IN1P + D_K + g * 64, L1 + (size_t)(nb * SEQ) * IN1P + D_K + ng * 64, D_V - D_K, IN1P, 0, qt >> 1, qf, st, mk, tid, lane, P.ka, P.va, P.kb, P.vb, [&]() {
#pragma unroll
        for (int e = 0; e < 4; ++e) { const int idx = tid + e * NTHR; MASKL[(idx >> 6) * 65 + (idx & 63)] = mwd[e]; }
#pragma unroll
        for (int ks = 0; ks < 4; ++ks) qf[ks] = scale_frag(qf[ks], 0.125f * 1.4426950408889634f); });
    P.odd = ((qt >> 1) + 1) & 1;
    if ((qt >> 1) == 0) {
        const bf16* ngp = L1 + (size_t)(nb * SEQ + (tid >> 3)) * IN1P + D_K + ng * 64 + (tid & 7) * 8;
        P.kb = *(const u32x4*)ngp; P.vb = *(const u32x4*)(ngp + (D_V - D_K)); }
    dsa_attn_front(F, itn, P);
    f32x16 f0, f1;
#pragma unroll
    for (int r = 0; r < 16; ++r) { f0[r] = 0.f; f1[r] = 0.f; }
    { const float lt = sum_x32(st.o2[0]), sc = lt > 0.f ? __builtin_amdgcn_rcpf(lt) : 0.f;
#pragma unroll
      for (int r = 0; r < 16; ++r) { f0[r] = sc * st.o0[r]; f1[r] = sc * st.o1[r]; } }
    bf16* Y = (bf16*)(F.ws + WS_Y);
    {
        bf16* ybase = Y + (size_t)(b * SEQ + qt * 32) * DM + head * 64;
        store_rows_staged(F.lds + w * 4608, f0, f1, lane, [&](int ri) { return ybase + (size_t)ri * DM; });
    }
}

#ifndef REP_P0
#define REP_P0 1
#endif
#ifndef REP_NORM
#define REP_NORM 1
#endif
#ifndef REP_GIN0
#define REP_GIN0 1
#endif
#ifndef REP_LRU1
#define REP_LRU1 1
#endif
#ifndef REP_NSA
#define REP_NSA 1
#endif
#ifndef REP_GGU
#define REP_GGU 1
#endif
#ifndef REP_DIDX
#define REP_DIDX 1
#endif
#ifndef REP_DATT
#define REP_DATT 1
#endif
__global__ void __launch_bounds__(NTHR) fwd_megakernel(Args args) {
    extern __shared__ __attribute__((aligned(16))) unsigned char lds_raw[];
    Frame F;
    F.lds = (LAS unsigned char*)lds_raw;
    F.tid = threadIdx.x; F.lane = F.tid & 63; F.wave = __builtin_amdgcn_readfirstlane(F.tid >> 6);
    F.G = gridDim.x; F.bid = blockIdx.x;
    F.in = args.in; F.out = args.out; F.ws = args.ws;
    unsigned char* ws = args.ws;
    const float* MOD0 = (const float*)(ws + WS_MOD0); const float* MOD1 = (const float*)(ws + WS_MOD1);
    bf16* X16 = (bf16*)(ws + WS_X16);
    bf16* XN = (bf16*)(ws + WS_XN); bf16* BIG = (bf16*)(ws + WS_BIG); bf16* Y = (bf16*)(ws + WS_Y);
    typedef pg8::StaticOrder SO;
#ifdef REP_K
    typedef pg8::DoubleOrder SOK;
#else
    typedef pg8::StaticOrder SOK;
#endif
    volatile LAS unsigned* MISC = (volatile LAS unsigned*)(F.lds + 131072 + 18432 + 512);
    if (F.tid < 32) MISC[F.tid] = 0u;
    __syncthreads();
    const XcdBarrier bar = xcd_barrier_post((unsigned*)ws, MISC + 8);
#define GRID_SYNC() xcd_barrier(bar)
    if (F.tid == 0) ((unsigned*)ws)[GB_XID(F.bid)] = bar.x + 1u;
#define NROW0 (256 * (16 * (F.bid & 7) + 4 * (F.bid >> 6) + ((F.bid >> 3) & 3)) + 128 * ((F.bid >> 5) & 1))
#define OFF_ (F.bid >> 3)
#define B2_ (2 * (F.bid & 7) + (OFF_ & 1))
#define VB_LRU ((B2_ << 4) | (OFF_ >> 1))
#define VB_CMP (((OFF_ >> 4) << 7) | (B2_ << 3) | ((OFF_ >> 1) & 7))
#define VB_ATT ((B2_ << 1) | ((OFF_ >> 1) & 1) | ((OFF_ >> 2) << 5))
#define VB_IDX (B2_ | ((OFF_ >> 1) << 4))
#define GRP_SYNC(e) grp_barrier(GrpBarrier{(unsigned*)ws, (unsigned)GB_CNT((F.bid & 7) * 4 + ((F.bid >> 3) & 3)), 8u, MISC + 12}, (e))
#define XCD_SYNC(e) grp_barrier(GrpBarrier{(unsigned*)ws, (unsigned)XG_CNT(F.bid & 7), 32u, MISC + 13}, (e))
#ifdef NO_SPLIT_FENCE
#define SPLIT_ARRIVE(i) split_arrive((unsigned*)ws, (i))
#else
#define SPLIT_ARRIVE(i) do { if (F.tid == 0) { __builtin_amdgcn_fence(__ATOMIC_RELEASE, "agent"); asm volatile("s_waitcnt vmcnt(0)" ::: "memory"); } split_arrive((unsigned*)ws, (i)); } while (0)
#endif
#define SPLIT_WAIT(i) split_wait((unsigned*)ws, (i), (unsigned)F.G)

#ifndef PHMASK
#define PHMASK 0xffffffu
#endif
#define PH(n) F.lane = fresh_lane(); F.tid = F.wave * 64 + F.lane; if (PHMASK & (1u << (n)))
    for (int rep_ = 0; rep_ < REP_P0; ++rep_) {
    PH(0) p0_prologue(F);
    GRID_SYNC();
    }
    if (F.tid == 0) {
        bool same8 = true, same32 = true;
        for (int k = 0; k < 32; ++k) { const bool s = xb_ld(&((unsigned*)ws)[GB_XID((F.bid & 7) + 8 * k)]) == bar.x + 1u; same32 = same32 && s; if ((k & 3) == ((F.bid >> 3) & 3)) same8 = same8 && s; }
        MISC[12] = same8 ? 2u : 1u; MISC[13] = same32 ? 2u : 1u;
#ifdef FORCE_SLOW_GB
        MISC[12] = 1u; MISC[13] = 1u;
#endif
    }
    for (int rep_ = 0; rep_ < REP_NORM; ++rep_) {
    PH(1) norm_mod_phase(F, F.in[0], F.in[2], MOD0 + 0, MOD0 + 1024, XN, NROW0, 128);
    GRP_SYNC(1 + rep_);
    }
    for (int rep_ = 0; rep_ < REP_GIN0; ++rep_) {
    PH(2) { pg8::Gemm g{XN, (const bf16*)(ws + WS_WIN0), MROWS, IN0P, DM}; SO S; S.init(MROWS, IN0P, F.G, F.bid); pg8::EpiStoreBf16 E{BIG, IN0P};
      pg8::gemm_phase<pg8::EpiStoreBf16, SO, true, true>(F.lds, g, S, E, F.wave); }
    }
    XCD_SYNC(1);
    for (int rep_ = 0; rep_ < REP_LRU1; ++rep_) {
    { PH(3) lru_fused_item(F, VB_LRU); } { PH(4) cmp_item(F, VB_CMP); }
    }
    XCD_SYNC(2);
    for (int rep_ = 0; rep_ < REP_NSA; ++rep_) {
    _Pragma("unroll 1") for (int k = 0; k < 4; ++k) { PH(5) nsa_item(F, VB_ATT + 256 * k); }
    }
    XCD_SYNC(3);
    SPLIT_ARRIVE(0);
    PH(7) { pg8::Gemm g{Y, (const bf16*)(ws + WS_WOUT0), MROWS, DM, DM}; SO S; S.init(MROWS, DM, F.G, F.bid); pg8::EpiResGate16<true> E{F.in[0], X16, MOD0 + 2048, 6144};
      pg8::gemm_phase<pg8::EpiResGate16<true>, SO, true, true>(F.lds, g, S, E, F.wave); }
    GRP_SYNC(REP_NORM + 1);
    PH(8) norm_mod_phase16(F, X16, F.in[3], MOD0 + 3072, MOD0 + 4096, XN, NROW0, 128);
    GRP_SYNC(REP_NORM + 2);
    SPLIT_WAIT(0);
    for (int rep_ = 0; rep_ < REP_GGU; ++rep_) {
    PH(9) { pg8::Gemm g{XN, (const bf16*)(ws + WS_WGU0), MROWS, 2 * DFF, DM}; SOK S; S.init(MROWS, 2 * DFF, F.G, F.bid); pg8::EpiSwiGLU E{BIG, DFF};
      pg8::gemm_phase<pg8::EpiSwiGLU, SOK, true, true>(F.lds, g, S, E, F.wave); }
    }
    GRP_SYNC(REP_NORM + 3);
    PH(10) { pg8::Gemm g{BIG, (const bf16*)(ws + WS_WD0), MROWS, DM, DFF}; SO S; S.init(MROWS, DM, F.G, F.bid); pg8::EpiResGate16<false> E{X16, X16, MOD0 + 5120, 6144};
      pg8::gemm_phase<pg8::EpiResGate16<false>, SO, true, true>(F.lds, g, S, E, F.wave); }
    GRP_SYNC(REP_NORM + 4);
    SPLIT_ARRIVE(1);
    PH(11) norm_mod_phase16(F, X16, F.in[24], MOD1 + 0, MOD1 + 1024, XN, NROW0, 128);
    GRP_SYNC(REP_NORM + 5);
    SPLIT_WAIT(1);
    PH(12) { pg8::Gemm g{XN, (const bf16*)(ws + WS_WIN1), MROWS, IN1P, DM}; SO S; S.init(MROWS, IN1P, F.G, F.bid); pg8::EpiStoreBf16 E{BIG, IN1P};
      pg8::gemm_phase<pg8::EpiStoreBf16, SO, true, true>(F.lds, g, S, E, F.wave); }
    XCD_SYNC(4);
    for (int rep_ = 0; rep_ < REP_DIDX; ++rep_) {
    PH(13) { IdxPre P_; dsa_index_front(F, VB_IDX, P_);
      _Pragma("unroll 1") for (int k = 0; k < 8; ++k) dsa_index_item(F, VB_IDX + 256 * k, VB_IDX + 256 * (k < 7 ? k + 1 : k), P_); }
    }
    XCD_SYNC(5);
    for (int rep_ = 0; rep_ < REP_DATT; ++rep_) {
    PH(14) { DsaPre P_; dsa_attn_front(F, VB_ATT, P_); dsa_attn_front_kv(F, VB_ATT, P_);
      _Pragma("unroll 1") for (int k = 0; k < 8; ++k) dsa_attn_item(F, VB_ATT + 256 * k, VB_ATT + 256 * (k < 7 ? k + 1 : k), P_); }
    }
    XCD_SYNC(6);
    SPLIT_ARRIVE(2);
    PH(15) { pg8::Gemm g{Y, (const bf16*)(ws + WS_WOUT1), MROWS, DM, DM}; SO S; S.init(MROWS, DM, F.G, F.bid); pg8::EpiResGate16<false> E{X16, X16, MOD1 + 2048, 6144};
      pg8::gemm_phase<pg8::EpiResGate16<false>, SO, true, true>(F.lds, g, S, E, F.wave); }
    GRP_SYNC(REP_NORM + 6);
    PH(16) norm_mod_phase16(F, X16, F.in[25], MOD1 + 3072, MOD1 + 4096, XN, NROW0, 128);
    GRP_SYNC(REP_NORM + 7);
    SPLIT_WAIT(2);
    PH(17) { pg8::Gemm g{XN, (const bf16*)(ws + WS_WGU1), MROWS, 2 * DFF, DM}; SOK S; S.init(MROWS, 2 * DFF, F.G, F.bid); pg8::EpiSwiGLU E{BIG, DFF};
      pg8::gemm_phase<pg8::EpiSwiGLU, SOK, true, true>(F.lds, g, S, E, F.wave); }
    GRP_SYNC(REP_NORM + 8);
    PH(18) { pg8::Gemm g{BIG, (const bf16*)(ws + WS_WD1), MROWS, DM, DFF}; SO S; S.init(MROWS, DM, F.G, F.bid); pg8::EpiResGate16<false> E{X16, X16, MOD1 + 5120, 6144};
      pg8::gemm_phase<pg8::EpiResGate16<false>, SO, true, true>(F.lds, g, S, E, F.wave); }
    GRP_SYNC(REP_NORM + 9);
    PH(19) final_norm_phase16(F, X16, F.out, F.in[33], NROW0, 128);
}

extern "C" void kernel_launch(void* const* d_in, const int* in_sizes, int n_in, void* d_out, int out_size, void* d_ws, size_t ws_size, hipStream_t stream) {
    static int grid = 0;
    if (grid == 0) {
        if (n_in != 34 || in_sizes[0] != MROWS * DM || out_size != MROWS * DM || ws_size < WS_END) {
            fprintf(stderr, "kernel_launch: unexpected shapes (n_in %d, in0 %d, out %d, ws %zu); nothing launched\n", n_in, n_in > 0 ? in_sizes[0] : -1, out_size, ws_size); grid = -1; return; }
        int dev = 0, cus = 0, per_cu = 0;
        if (hipGetDevice(&dev) != hipSuccess || hipDeviceGetAttribute(&cus, hipDeviceAttributeMultiprocessorCount, dev) != hipSuccess) { grid = -1; return; }
        if (hipFuncSetAttribute((const void*)fwd_megakernel, hipFuncAttributeMaxDynamicSharedMemorySize, LDS_BYTES) != hipSuccess) { fprintf(stderr, "kernel_launch: hipFuncSetAttribute failed\n"); grid = -1; return; }
        if (hipOccupancyMaxActiveBlocksPerMultiprocessor(&per_cu, (const void*)fwd_megakernel, NTHR, LDS_BYTES) != hipSuccess || per_cu < 1) { fprintf(stderr, "kernel_launch: occupancy query says %d\n", per_cu); grid = -1; return; }
        if (cus != 256) { fprintf(stderr, "kernel_launch: the row-group work split needs 256 CUs (MI355X), found %d; nothing launched\n", cus); grid = -1; return; }
        grid = cus;
    }
    if (grid < 0) return;
    Args a{};
    for (int i = 0; i < 34; ++i) a.in[i] = (const float*)d_in[i];
    a.out = (float*)d_out; a.ws = (unsigned char*)d_ws;
    if (hipMemsetAsync(d_ws, 0, 32768, stream) != hipSuccess) { fprintf(stderr, "kernel_launch: memset of the barrier words failed\n"); return; }
    hipLaunchKernelGGL(fwd_megakernel, dim3(grid), dim3(NTHR), LDS_BYTES, stream, a);
    const hipError_t e = hipPeekAtLastError();
    if (e != hipSuccess) fprintf(stderr, "kernel_launch: launch failed: %s (grid %d)\n", hipGetErrorName(e), grid);
}
```

```cpp
#include <hip/hip_runtime.h>
#include <cstdio>
#include <cstdint>

namespace pg8 {
#define PG8_LAS __attribute__((address_space(3)))
typedef unsigned short bf16_t;
typedef short bf16x8 __attribute__((ext_vector_type(8)));
typedef float f32x4 __attribute__((ext_vector_type(4)));
typedef unsigned u32x4 __attribute__((ext_vector_type(4)));
constexpr int BM = 256, BK = 64, HALF = 128, HTB = HALF * BK * 2  , STAGE_BYTES = 8 * HTB, NXCD = 8, WGM = 4;

__host__ __device__ __forceinline__ int lds_byte(int r, int c) { const int st = (r >> 4) * 2 + (c >> 5), rr = r & 15, cc = c & 31, ob = rr * 64 + cc * 2; return st * 1024 + (ob ^ (((ob >> 9) & 1) << 5)); }
__host__ __device__ __forceinline__ void stage_rc(int b, int& R, int& C) { const int st = b / 1024, sb = b % 1024, swz = sb ^ (((sb >> 9) & 1) << 5); R = (st >> 1) * 16 + swz / 64; C = (st & 1) * 32 + (swz % 64) / 2; }
__host__ __device__ __forceinline__ int perm32(int rho) { const int n = rho >> 4, i = rho & 15; return 8 * (i >> 2) + 4 * n + (i & 3); }

#ifdef REP_K
struct Unit { int pm, pn, skip; };
#else
struct Unit { int pm, pn; };
#endif
struct Gemm { const bf16_t* A; const bf16_t* Bt; int M, N, K; void* dummy; };

struct StaticOrder {
    int nM, nN, nwg, G, c;
    __host__ __device__ void init(int M, int N, int G_, int c_) { nM = M / BM; nN = N / BM; nwg = nM * nN; G = G_; c = c_; }
    __host__ __device__ bool next(int i, Unit& u) const {
        const long L = (long)i * G + c; if (L >= nwg) return false;
        int wgid = (int)L; { const int q = nwg / NXCD, r = nwg % NXCD, xcd = wgid % NXCD, off = wgid / NXCD; wgid = (xcd < r ? xcd * (q + 1) : r * (q + 1) + (xcd - r) * q) + off; }
        const int nig = WGM * nN, gid = wgid / nig, fm = gid * WGM, gsz = (nM - fm) < WGM ? (nM - fm) : WGM;
        u.pm = fm + ((wgid % nig) % gsz); u.pn = (wgid % nig) / gsz;
#ifdef REP_K
        u.skip = 0;
#endif
        return true;
    }
    __device__ __forceinline__ void a_ready(const Unit&) const {}
    __device__ __forceinline__ void done(const Unit&) const {}
};
#ifdef REP_K
struct DoubleOrder {
    StaticOrder in;
    __host__ __device__ void init(int M, int N, int G_, int c_) { in.init(M, N, G_, c_); }
    __host__ __device__ bool next(int i, Unit& u) const { const bool ok = in.next(i >> 1, u); u.skip = !(i & 1); return ok; }
    __device__ __forceinline__ void a_ready(const Unit&) const {}
    __device__ __forceinline__ void done(const Unit&) const {}
};
#endif

typedef float f32x2v __attribute__((ext_vector_type(2)));
typedef __bf16 bf16x2v __attribute__((ext_vector_type(2)));
typedef unsigned u32x2 __attribute__((ext_vector_type(2)));
__device__ __forceinline__ unsigned cvt_pk_bf16(float lo, float hi) { f32x2v v = {lo, hi}; bf16x2v b = __builtin_convertvector(v, bf16x2v); return __builtin_bit_cast(unsigned, b); }

struct EpiStoreBf16 {
    static constexpr bool PERM = true, AFTER_DRAIN = false, IDEMP = true, HAS_DUMMY = true, PERM64 = true; static constexpr int NSTORE = 16;
    bf16_t* O; int ldc;
    __device__ __forceinline__ void operator()(const f32x4 (&acc)[2][2][4][2], const Unit& u, int wr, int wc, int fr, int fq) const {
        const int row0 = u.pm * BM + wr * 64 + (fr & 7), col0 = u.pn * BM + wc * 64 + 8 * ((fr >> 3) * 4 + fq);
#pragma unroll
        for (int ai = 0; ai < 2; ++ai)
#pragma unroll
            for (int m = 0; m < 4; ++m) { bf16_t* rowp = O + (size_t)(row0 + ai * HALF + m * 16) * ldc + col0;
                u32x4 w[2];
#pragma unroll
                for (int bj = 0; bj < 2; ++bj) { const f32x4 v0 = acc[ai][bj][m][0], v1 = acc[ai][bj][m][1];
                    w[bj].x = cvt_pk_bf16(v0[0], v0[1]); w[bj].y = cvt_pk_bf16(v0[2], v0[3]); w[bj].z = cvt_pk_bf16(v1[0], v1[1]); w[bj].w = cvt_pk_bf16(v1[2], v1[3]); }
                u32x4 lo, hi;
#pragma unroll
                for (int e = 0; e < 4; ++e) { lo[e] = (unsigned)__builtin_amdgcn_update_dpp((int)w[0][e], (int)w[1][e], 0x128, 0xF, 0xC, false);
                                              hi[e] = (unsigned)__builtin_amdgcn_update_dpp((int)w[1][e], (int)w[0][e], 0x128, 0xF, 0x3, false); }
                *(u32x4*)rowp = lo; *(u32x4*)(rowp + (size_t)8 * ldc) = hi; }
    }
#ifdef EPI_DUMMY
    __device__ __forceinline__ void dummy(const f32x4 (&acc)[2][2][4][2], const Unit& u, int wr, int wc, int fr, int fq, bf16_t* D) const {
        const int row0 = (u.pm & 15) * BM + wr * 64 + fr, col0 = u.pn * BM + wc * 32 + 8 * fq;
        const int lin = ((u.pm * 16 + u.pn) & 127) * 8 + wr * 4 + wc;
#pragma unroll
        for (int ai = 0; ai < 2; ++ai)
#pragma unroll
            for (int m = 0; m < 4; ++m) { bf16_t* rowp = D + (size_t)(row0 + ai * HALF + m * 16) * ldc + col0;
#pragma unroll
                for (int bj = 0; bj < 2; ++bj) { const f32x4 v0 = acc[ai][bj][m][0], v1 = acc[ai][bj][m][1];
                    u32x4 w; w.x = cvt_pk_bf16(v0[0], v0[1]); w.y = cvt_pk_bf16(v0[2], v0[3]); w.z = cvt_pk_bf16(v1[0], v1[1]); w.w = cvt_pk_bf16(v1[2], v1[3]);
                    if (EPI_DUMMY == 1) *(u32x4*)(rowp + bj * HALF) = w;
                    else *(u32x4*)(D + (size_t)lin * 8192 + ((ai * 4 + m) * 2 + bj) * 512 + (fq * 16 + fr) * 8) = w; } }
    }
#endif
};
struct EpiResGate {
    static constexpr bool PERM = false, AFTER_DRAIN = false, IDEMP = false, HAS_DUMMY = false, PERM64 = false; static constexpr int NSTORE = 32;
    const float* res; float* out; const float* gate; int gpitch;
    __device__ __forceinline__ void operator()(const f32x4 (&acc)[2][2][4][2], const Unit& u, int wr, int wc, int fr, int fq) const {
        const int row0 = u.pm * BM + wr * 64 + fr, col0 = u.pn * BM + wc * 32 + 4 * fq;
        const float* gp = gate + (size_t)(u.pm >> 3) * gpitch + col0;
        f32x4 gv[2][2];
#pragma unroll
        for (int bj = 0; bj < 2; ++bj)
#pragma unroll
            for (int n = 0; n < 2; ++n) gv[bj][n] = *(const f32x4*)(gp + bj * HALF + n * 16);
#pragma unroll
        for (int ai = 0; ai < 2; ++ai)
#pragma unroll
            for (int m = 0; m < 4; ++m) { const size_t off = (size_t)(row0 + ai * HALF + m * 16) * 1024 + col0;
#pragma unroll
                for (int bj = 0; bj < 2; ++bj)
#pragma unroll
                    for (int n = 0; n < 2; ++n) { const f32x4 r = *(const f32x4*)(res + off + bj * HALF + n * 16);
                        *(f32x4*)(out + off + bj * HALF + n * 16) = r + gv[bj][n] * acc[ai][bj][m][n]; } }
    }
};
struct EpiSwiGLU {
    static constexpr bool PERM = true, AFTER_DRAIN = false, IDEMP = true, HAS_DUMMY = false, PERM64 = false; static constexpr int NSTORE = 8;
    bf16_t* O; int ldc;
    __device__ __forceinline__ void operator()(const f32x4 (&acc)[2][2][4][2], const Unit& u, int wr, int wc, int fr, int fq) const {
        const int row0 = u.pm * BM + wr * 64 + fr, col0 = u.pn * HALF + wc * 32 + 8 * fq;
#pragma unroll
        for (int ai = 0; ai < 2; ++ai)
#pragma unroll
            for (int m = 0; m < 4; ++m) { bf16_t* rowp = O + (size_t)(row0 + ai * HALF + m * 16) * ldc + col0; u32x4 w;
#pragma unroll
                for (int n = 0; n < 2; ++n) { const f32x4 g = acc[ai][0][m][n], up = acc[ai][1][m][n]; f32x4 o;
#pragma unroll
                    for (int e = 0; e < 4; ++e) o[e] = g[e] * up[e] * __builtin_amdgcn_rcpf(1.0f + __expf(-g[e]));
#ifdef EPI_VALU2
#pragma unroll
                    for (int e = 0; e < 4; ++e) { float g2 = g[e]; asm volatile("" : "+v"(g2)); const float t = g2 * up[e] * __builtin_amdgcn_rcpf(1.0f + __expf(-g2)); o[e] = 0.5f * (o[e] + t); }
#endif
                    w[2 * n] = cvt_pk_bf16(o[0], o[1]); w[2 * n + 1] = cvt_pk_bf16(o[2], o[3]); }
                *(u32x4*)rowp = w; }
    }
};

template <bool RES32> struct EpiResGate16 {
    static constexpr bool PERM = true, AFTER_DRAIN = false, IDEMP = RES32, HAS_DUMMY = false, PERM64 = false; static constexpr int NSTORE = 16;
    const void* res; bf16_t* out; const float* gate; int gpitch;
    __device__ __forceinline__ void operator()(const f32x4 (&acc)[2][2][4][2], const Unit& u, int wr, int wc, int fr, int fq) const {
        const int row0 = u.pm * BM + wr * 64 + fr, col0 = u.pn * BM + wc * 32 + 8 * fq;
        const float* gp = gate + (size_t)(u.pm >> 3) * gpitch + col0;
        f32x4 gv[2][2];
#pragma unroll
        for (int bj = 0; bj < 2; ++bj)
#pragma unroll
            for (int n = 0; n < 2; ++n) gv[bj][n] = *(const f32x4*)(gp + bj * HALF + n * 4);
        if constexpr (RES32) {
#pragma unroll
            for (int ai = 0; ai < 2; ++ai)
#pragma unroll
            for (int mh = 0; mh < 2; ++mh) {
                f32x4 r0[2][2], r1[2][2];
#pragma unroll
                for (int m2 = 0; m2 < 2; ++m2)
#pragma unroll
                    for (int bj = 0; bj < 2; ++bj) { const size_t off = (size_t)(row0 + ai * HALF + (2 * mh + m2) * 16) * 1024 + col0 + bj * HALF;
                        r0[m2][bj] = *(const f32x4*)((const float*)res + off); r1[m2][bj] = *(const f32x4*)((const float*)res + off + 4); }
                __builtin_amdgcn_sched_barrier(0);
#pragma unroll
                for (int m2 = 0; m2 < 2; ++m2)
#pragma unroll
                    for (int bj = 0; bj < 2; ++bj) { const int m = 2 * mh + m2; const size_t off = (size_t)(row0 + ai * HALF + m * 16) * 1024 + col0 + bj * HALF;
                        const f32x4 v0 = r0[m2][bj] + gv[bj][0] * acc[ai][bj][m][0], v1 = r1[m2][bj] + gv[bj][1] * acc[ai][bj][m][1];
                        u32x4 w; w.x = cvt_pk_bf16(v0[0], v0[1]); w.y = cvt_pk_bf16(v0[2], v0[3]); w.z = cvt_pk_bf16(v1[0], v1[1]); w.w = cvt_pk_bf16(v1[2], v1[3]);
                        *(u32x4*)(out + off) = w; }
            }
        } else {
            u32x4 rb[4][2];
#pragma unroll
            for (int m = 0; m < 4; ++m)
#pragma unroll
                for (int bj = 0; bj < 2; ++bj) rb[m][bj] = *(const u32x4*)((const bf16_t*)res + (size_t)(row0 + m * 16) * 1024 + col0 + bj * HALF);
            __builtin_amdgcn_sched_barrier(0);
#pragma unroll
            for (int ai = 0; ai < 2; ++ai)
#pragma unroll
                for (int m = 0; m < 4; ++m)
#pragma unroll
                    for (int bj = 0; bj < 2; ++bj) { const size_t off = (size_t)(row0 + ai * HALF + m * 16) * 1024 + col0 + bj * HALF; const u32x4 q = rb[m][bj];
                        if (ai == 0) rb[m][bj] = *(const u32x4*)((const bf16_t*)res + off + (size_t)HALF * 1024);
                        const f32x4 r0 = (f32x4){__builtin_bit_cast(float, q.x << 16), __builtin_bit_cast(float, q.x & 0xffff0000u), __builtin_bit_cast(float, q.y << 16), __builtin_bit_cast(float, q.y & 0xffff0000u)};
                        const f32x4 r1 = (f32x4){__builtin_bit_cast(float, q.z << 16), __builtin_bit_cast(float, q.z & 0xffff0000u), __builtin_bit_cast(float, q.w << 16), __builtin_bit_cast(float, q.w & 0xffff0000u)};
                        const f32x4 v0 = r0 + gv[bj][0] * acc[ai][bj][m][0], v1 = r1 + gv[bj][1] * acc[ai][bj][m][1];
                        u32x4 w; w.x = cvt_pk_bf16(v0[0], v0[1]); w.y = cvt_pk_bf16(v0[2], v0[3]); w.z = cvt_pk_bf16(v1[0], v1[1]); w.w = cvt_pk_bf16(v1[2], v1[3]);
                        *(u32x4*)(out + off) = w; }
        }
    }
};

template <class Epi, class Sched, bool ALIGN_EPI = false, bool SP2 = false>
__device__ __forceinline__ void gemm_phase(PG8_LAS unsigned char* lds, const Gemm g, const Sched& S, const Epi& E, const int wid_in  ) {
    int tid_; asm volatile("v_mbcnt_lo_u32_b32 %0, -1, 0\n\tv_mbcnt_hi_u32_b32 %0, -1, %0" : "=v"(tid_)); tid_ += 64 * wid_in;
    const int tid = tid_, wid = wid_in, lane = tid & 63, wr = wid >> 2, wc = wid & 3, fr = lane & 15, fq = lane >> 4;
    const int K = g.K, nt = K / BK;
    unsigned voffA[2], voffB[2];
#pragma unroll
    for (int i = 0; i < 2; ++i) { int R, C; stage_rc(tid * 16 + i * 8192, R, C); const int Rb = Epi::PERM64 ? (64 * (R >> 5) + perm32(R & 31)) : Epi::PERM ? ((R & ~31) + perm32(R & 31)) : R;
        voffA[i] = (unsigned)(R * K + C) * 2u; voffB[i] = (unsigned)(Rb * K + C) * 2u; }
    const size_t kstep = (size_t)(BK * 2);
    const size_t hstep = (size_t)HALF * K * 2;
    const size_t tstep = 2 * hstep;
    const size_t bhstep = Epi::PERM64 ? (size_t)32 * K * 2 : hstep;
    const unsigned ldsw = (unsigned)wid * 1024u;
    const int aoff = lds_byte(wr * 64 + fr, fq * 8), boff = lds_byte(wc * 32 + fr, fq * 8);
#define PG8_SA(b, h) (((b) * 2 + (h)) * HTB)
#define PG8_SB(b, h) ((4 + (b) * 2 + (h)) * HTB)
#define PG8_STAGE(bufoff, gbase, voff) do { _Pragma("unroll") for (int _i = 0; _i < 2; ++_i) \
        __builtin_amdgcn_global_load_lds((const unsigned*)((const char*)(gbase) + (voff)[_i]), (PG8_LAS unsigned*)(lds + (bufoff) + ldsw + _i * 8192), 16, 0, 0); } while (0)
#define PG8_LDA(dst, b, h) do { _Pragma("unroll") for (int m = 0; m < 4; ++m) _Pragma("unroll") for (int k = 0; k < 2; ++k) dst[m][k] = *(const PG8_LAS bf16x8*)(lds + PG8_SA(b, h) + aoff + m * 2048 + k * 1024); } while (0)
#define PG8_LDB(dst, b, h) do { _Pragma("unroll") for (int n = 0; n < 2; ++n) _Pragma("unroll") for (int k = 0; k < 2; ++k) dst[n][k] = *(const PG8_LAS bf16x8*)(lds + PG8_SB(b, h) + boff + n * 2048 + k * 1024); } while (0)
#define PG8_MMA(ai, bj, At, Bt) do { __builtin_amdgcn_s_setprio(1); _Pragma("unroll") for (int m = 0; m < 4; ++m) _Pragma("unroll") for (int n = 0; n < 2; ++n) _Pragma("unroll") for (int k = 0; k < 2; ++k) \
        acc[ai][bj][m][n] = __builtin_amdgcn_mfma_f32_16x16x32_bf16(Bt[n][k], At[m][k], acc[ai][bj][m][n], 0, 0, 0); __builtin_amdgcn_s_setprio(0); } while (0)
#define PG8_WAIT_V(n) asm volatile("s_waitcnt vmcnt(" #n ")" ::: "memory")
#define PG8_WAIT_L(n) asm volatile("s_waitcnt lgkmcnt(" #n ")" ::: "memory")
#define PG8_BAR __builtin_amdgcn_s_barrier()
#define PG8_SCHED __builtin_amdgcn_sched_barrier(0)
    Unit cur, nxt; int ui = 0;
    if (!S.next(0, cur)) return;
    f32x4 acc[2][2][4][2];
#pragma unroll
    for (int a = 0; a < 2; ++a)
#pragma unroll
        for (int b = 0; b < 2; ++b)
#pragma unroll
            for (int m = 0; m < 4; ++m)
#pragma unroll
                for (int n = 0; n < 2; ++n) acc[a][b][m][n] = (f32x4){0.f, 0.f, 0.f, 0.f};
    bf16x8 At[4][2], B0[2][2], B1[2][2];
    const char* cA = (const char*)g.A + (size_t)cur.pm * tstep; const char* cB = (const char*)g.Bt + (size_t)cur.pn * tstep;
    S.a_ready(cur);
    if constexpr (SP2) {
        PG8_STAGE(PG8_SB(0, 0), cB, voffB); PG8_STAGE(PG8_SB(0, 1), cB + bhstep, voffB); PG8_STAGE(PG8_SA(0, 0), cA, voffA); PG8_STAGE(PG8_SA(0, 1), cA + hstep, voffA);
        if (wr == 1) PG8_BAR;
        PG8_WAIT_V(2); PG8_BAR;
        PG8_STAGE(PG8_SB(1, 0), cB + kstep, voffB); PG8_STAGE(PG8_SA(1, 0), cA + kstep, voffA); PG8_STAGE(PG8_SB(1, 1), cB + bhstep + kstep, voffB);
        PG8_WAIT_V(6); PG8_BAR;
    } else {
        PG8_STAGE(PG8_SB(0, 0), cB, voffB); PG8_STAGE(PG8_SA(0, 0), cA, voffA); PG8_STAGE(PG8_SB(0, 1), cB + bhstep, voffB); PG8_STAGE(PG8_SA(0, 1), cA + hstep, voffA);
        if (wr == 1) PG8_BAR;
        PG8_WAIT_V(4); PG8_BAR;
        PG8_STAGE(PG8_SB(1, 0), cB + kstep, voffB); PG8_STAGE(PG8_SA(1, 0), cA + kstep, voffA); PG8_STAGE(PG8_SB(1, 1), cB + bhstep + kstep, voffB);
        PG8_WAIT_V(6); PG8_BAR;
    }
    for (;;) {
        const bool has_next = S.next(ui + 1, nxt);
        const char* nA = has_next ? (const char*)g.A + (size_t)nxt.pm * tstep : cA; const char* nB = has_next ? (const char*)g.Bt + (size_t)nxt.pn * tstep : cB;
        for (int t = 0; t < nt; t += 2) {
            const bool last = (t == nt - 2);
            const char* a1 = cA + (size_t)(t + 1) * kstep;
            const char* a2 = last ? nA : cA + (size_t)(t + 2) * kstep; const char* b2 = last ? nB : cB + (size_t)(t + 2) * kstep;
            const char* a3 = a2 + kstep; const char* b3 = b2 + kstep;
            if (last && has_next) S.a_ready(nxt);
            if constexpr (SP2) {
            const int after_epi = __builtin_amdgcn_readfirstlane(((t == 0) && (ui > 0)) ? 1 : 0);
#define PG8_WAIT_V8E_(NN) asm volatile("s_waitcnt vmcnt(" #NN ")\n\ts_cmp_lg_u32 %0, 0\n\ts_cbranch_scc1 .Lpg8w_%=\n\ts_waitcnt vmcnt(8)\n.Lpg8w_%=:" :: "s"(after_epi) : "memory", "scc")
#define PG8_WAIT_V8E do { if constexpr (Epi::NSTORE == 16) PG8_WAIT_V8E_(24); else PG8_WAIT_V8E_(16); } while (0)
            PG8_LDB(B0, 0, 0); PG8_LDB(B1, 0, 1); PG8_SCHED; PG8_LDA(At, 0, 0); PG8_STAGE(PG8_SA(1, 1), a1 + hstep, voffA);
            PG8_WAIT_V8E; PG8_WAIT_L(0); PG8_BAR; PG8_MMA(0, 0, At, B0); PG8_MMA(0, 1, At, B1); PG8_BAR; PG8_SCHED;
            PG8_LDA(At, 0, 1); PG8_STAGE(PG8_SB(0, 0), b2, voffB); PG8_STAGE(PG8_SB(0, 1), b2 + bhstep, voffB); PG8_STAGE(PG8_SA(0, 0), a2, voffA);
            PG8_WAIT_V8E; PG8_WAIT_L(0); PG8_BAR; PG8_MMA(1, 0, At, B0); PG8_MMA(1, 1, At, B1); PG8_BAR; PG8_SCHED;
#undef PG8_WAIT_V8E
#undef PG8_WAIT_V8E_
            PG8_LDB(B0, 1, 0); PG8_LDB(B1, 1, 1); PG8_SCHED; PG8_LDA(At, 1, 0); PG8_STAGE(PG8_SA(0, 1), a2 + hstep, voffA);
            PG8_WAIT_V(8); PG8_WAIT_L(0); PG8_BAR; PG8_MMA(0, 0, At, B0); PG8_MMA(0, 1, At, B1); PG8_BAR; PG8_SCHED;
            PG8_LDA(At, 1, 1); PG8_STAGE(PG8_SB(1, 0), b3, voffB); PG8_STAGE(PG8_SB(1, 1), b3 + bhstep, voffB); PG8_STAGE(PG8_SA(1, 0), a3, voffA);
            PG8_WAIT_V(8); PG8_WAIT_L(0); PG8_BAR; PG8_MMA(1, 0, At, B0); PG8_MMA(1, 1, At, B1); PG8_BAR; PG8_SCHED;
            } else {
            PG8_LDB(B0, 0, 0); PG8_SCHED; PG8_LDA(At, 0, 0); PG8_STAGE(PG8_SA(1, 1), a1 + hstep, voffA);
            PG8_WAIT_L(8); PG8_BAR; PG8_WAIT_L(0); PG8_MMA(0, 0, At, B0); PG8_BAR; PG8_SCHED;
            PG8_LDB(B1, 0, 1); PG8_STAGE(PG8_SB(0, 0), b2, voffB);
            PG8_BAR; PG8_WAIT_L(0); PG8_MMA(0, 1, At, B1); PG8_BAR;
            PG8_LDA(At, 0, 1); PG8_STAGE(PG8_SA(0, 0), a2, voffA);
            PG8_BAR; PG8_WAIT_L(0); PG8_MMA(1, 0, At, B0); PG8_BAR; PG8_SCHED;
            PG8_STAGE(PG8_SB(0, 1), b2 + bhstep, voffB);
            PG8_WAIT_V(6); PG8_BAR; PG8_MMA(1, 1, At, B1); PG8_BAR;
            PG8_LDB(B0, 1, 0); PG8_SCHED; PG8_LDA(At, 1, 0); PG8_STAGE(PG8_SA(0, 1), a2 + hstep, voffA);
            PG8_WAIT_L(8); PG8_BAR; PG8_WAIT_L(0); PG8_MMA(0, 0, At, B0); PG8_BAR; PG8_SCHED;
            PG8_LDB(B1, 1, 1); PG8_STAGE(PG8_SB(1, 0), b3, voffB);
            PG8_BAR; PG8_WAIT_L(0); PG8_MMA(0, 1, At, B1); PG8_BAR;
            PG8_LDA(At, 1, 1); PG8_STAGE(PG8_SA(1, 0), a3, voffA);
            PG8_BAR; PG8_WAIT_L(0); PG8_MMA(1, 0, At, B0); PG8_BAR; PG8_SCHED;
            PG8_STAGE(PG8_SB(1, 1), b3 + bhstep, voffB);
            PG8_WAIT_V(6); PG8_BAR; PG8_MMA(1, 1, At, B1); PG8_BAR;
            }
        }
        if constexpr (ALIGN_EPI) { if (wr == 0) PG8_BAR; }
#ifdef REP_K
        if (!cur.skip)
#endif
        if constexpr (!Epi::AFTER_DRAIN) { E(acc, cur, wr, wc, fr, fq);
#ifdef REP_EPI
#ifdef EPI_DUMMY
            if constexpr (Epi::HAS_DUMMY) { asm volatile("" ::: "memory"); E.dummy(acc, cur, wr, wc, fr, fq, (bf16_t*)g.dummy); }
#else
            if constexpr (Epi::IDEMP) { asm volatile("" ::: "memory"); E(acc, cur, wr, wc, fr, fq); }
#endif
#endif
            S.done(cur); }
        if (!has_next) break;
#pragma unroll
        for (int a = 0; a < 2; ++a)
#pragma unroll
            for (int b = 0; b < 2; ++b)
#pragma unroll
                for (int m = 0; m < 4; ++m)
#pragma unroll
                    for (int n = 0; n < 2; ++n) acc[a][b][m][n] = (f32x4){0.f, 0.f, 0.f, 0.f};
        cur = nxt; cA = nA; cB = nB; ++ui;
        if constexpr (ALIGN_EPI) { if (wr == 1) PG8_BAR; }
    }
    PG8_WAIT_V(0);
    if constexpr (!ALIGN_EPI) { if (wr == 0) PG8_BAR; }
    PG8_BAR;
    if constexpr (Epi::AFTER_DRAIN) { E.fused(acc, cur, wr, wc, fr, fq, lds, wid, lane); S.done(cur); }
#undef PG8_SA
#undef PG8_SB
#undef PG8_STAGE
#undef PG8_LDA
#undef PG8_LDB
#undef PG8_MMA
#undef PG8_WAIT_V
#undef PG8_WAIT_L
#undef PG8_BAR
#undef PG8_SCHED
}
}

constexpr int NB = 16, SEQ = 2048, DM = 1024, MROWS = NB * SEQ;
constexpr int IN0P = 2560, IN1P = 2048, IN0 = 2328, IN1 = 1864, DFF = 2816;
constexpr int BIGP = 2816;
constexpr int NTHR = 512, NWV = 8;
constexpr int C_AGATE = 0, C_AX = 512, C_Q = 1024, C_KC = 1536, C_VC = 1664, C_KS = 1792, C_VS = 1920, C_KW = 2048, C_VW = 2176, C_GT = 2304;
constexpr int D_Q = 0, D_K = 1024, D_V = 1152, D_QI = 1280, D_KI = 1792, D_WI = 1856;

constexpr size_t MiB = 1u << 20;
constexpr size_t WS_MOD0 = 64 * 1024, WS_MOD1 = WS_MOD0 + 16 * 6144 * 4, WS_CB1 = WS_MOD1 + 16 * 6144 * 4;
constexpr size_t WS_WIN0 = 4 * MiB, WS_WOUT0 = 9 * MiB, WS_WGU0 = 11 * MiB, WS_WD0 = 22 * MiB;
constexpr size_t WS_WIN1 = 28 * MiB, WS_WOUT1 = 32 * MiB, WS_WGU1 = 34 * MiB, WS_WD1 = 45 * MiB;
constexpr size_t WS_CW1K = 51 * MiB, WS_CW1V = WS_CW1K + 512 * 1024, WS_CW2K = 52 * MiB, WS_CW2V = WS_CW2K + 64 * 1024, WS_WAT = WS_CW2V + 64 * 1024, WS_WXT = WS_WAT + 64 * 1024;
constexpr size_t WS_XN = 56 * MiB;
constexpr size_t WS_BIG = 120 * MiB;
constexpr size_t WS_Y = 296 * MiB;
constexpr size_t WS_HL = 360 * MiB;
constexpr size_t WS_PC = 392 * MiB;
constexpr size_t WS_X16 = 424 * MiB;
constexpr size_t WS_KC = 488 * MiB, WS_VC = WS_KC + 512 * 1024;
constexpr size_t WS_MASK = 489 * MiB;
constexpr size_t WS_END = 497 * MiB;

constexpr int LDS_BYTES = 151552;

#define LAS __attribute__((address_space(3)))
typedef unsigned short bf16;
typedef short bf16x8 __attribute__((ext_vector_type(8)));
typedef short s16x4 __attribute__((ext_vector_type(4)));
typedef float f32x4 __attribute__((ext_vector_type(4)));
typedef float f32x16 __attribute__((ext_vector_type(16)));
typedef unsigned u32x4 __attribute__((ext_vector_type(4)));
typedef unsigned u32x2 __attribute__((ext_vector_type(2)));
#define DI __device__ __forceinline__
#define MFMA32(a, b, c) __builtin_amdgcn_mfma_f32_32x32x16_bf16((a), (b), (c), 0, 0, 0)

DI unsigned pk2(float lo, float hi) { return pg8::cvt_pk_bf16(lo, hi); }
DI bf16 f2bf(float f) { return (bf16)(pk2(f, 0.f) & 0xffffu); }
DI float bf2f(bf16 u) { return __uint_as_float((unsigned)u << 16); }
DI int crow(int r, int hi) { return (r & 3) + 8 * (r >> 2) + 4 * hi; }
DI float sigmoidf_(float x) { return __builtin_amdgcn_rcpf(1.0f + __expf(-x)); }
DI float gelu_tanh(float x) { const float z = 0.7978845608028654f * (x + 0.044715f * x * x * x); return x * sigmoidf_(2.0f * z); }
#define dppf(v, ctrl) __int_as_float(__builtin_amdgcn_update_dpp(0, __float_as_int(v), (ctrl), 0xf, 0xf, true))
#define DPP_XOR1 0xB1
#define DPP_XOR2 0x4E
#define DPP_HMIR 0x141
#define DPP_MIR  0x140
DI float xor16f(float v, bool oddrow) { auto rr = __builtin_amdgcn_permlane16_swap(__float_as_uint(v), __float_as_uint(v), false, false); return __uint_as_float(oddrow ? rr[0] : rr[1]); }
DI float wave_sum(float v) {
    v += dppf(v, DPP_XOR1); v += dppf(v, DPP_XOR2); v += dppf(v, DPP_HMIR); v += dppf(v, DPP_MIR);
    { auto rr = __builtin_amdgcn_permlane16_swap(__float_as_uint(v), __float_as_uint(v), false, false); v = __uint_as_float(rr[0]) + __uint_as_float(rr[1]); }
    { auto rr = __builtin_amdgcn_permlane32_swap(__float_as_uint(v), __float_as_uint(v), false, false); v = __uint_as_float(rr[0]) + __uint_as_float(rr[1]); }
    return v;
}
DI float max_x32(float v) { auto rr = __builtin_amdgcn_permlane32_swap(__float_as_uint(v), __float_as_uint(v), false, false); return fmaxf(__uint_as_float(rr[0]), __uint_as_float(rr[1])); }
DI float sum_x32(float v) { auto rr = __builtin_amdgcn_permlane32_swap(__float_as_uint(v), __float_as_uint(v), false, false); return __uint_as_float(rr[0]) + __uint_as_float(rr[1]); }
DI s16x4 vtr(const LAS char* p) { typedef short v4i16_t __attribute__((ext_vector_type(4))); return __builtin_bit_cast(s16x4, __builtin_amdgcn_ds_read_tr16_b64_v4i16((LAS v4i16_t*)p)); }

DI int opaque(int v) { asm volatile("" : "+v"(v)); return v; }
DI void lds_barrier() { asm volatile("s_waitcnt lgkmcnt(0)" ::: "memory"); __builtin_amdgcn_s_barrier(); asm volatile("" ::: "memory"); }
DI int fresh_lane() { int l; asm volatile("v_mbcnt_lo_u32_b32 %0, -1, 0\n\tv_mbcnt_hi_u32_b32 %0, -1, %0" : "=v"(l)); return l; }
struct Args { const float* in[34]; float* out; unsigned char* ws; };

struct Frame {
    LAS unsigned char* lds;
    int tid, lane, wave, G, bid;
    const float* const* in;
    float* out; unsigned char* ws;
};

#define GAS __attribute__((address_space(1)))
typedef GAS unsigned gu32;
typedef GAS unsigned long long gu64;
#define RLX_AGENT __ATOMIC_RELAXED, __HIP_MEMORY_SCOPE_AGENT
#define LDS_WAIT() asm volatile("s_waitcnt lgkmcnt(0)" ::: "memory")
#define VM_WAIT() asm volatile("s_waitcnt vmcnt(0)" ::: "memory")
__device__ __forceinline__ unsigned long long rt() { return __builtin_amdgcn_s_memrealtime(); }
#define XB_TMO      128
#define XB_XCNT(j)  (256  + 64 * (j))
#define XB_XSUB(j)  (1280 + 64 * (j))
#define XB_XGEN(j)  (2304 + 64 * (j))
#define XB_TOP      3328
#define XB_TOPGEN   3392
#define XCD_BAR_WORDS 3456
#define XB_SPIN_CAP (1u << 18)

__device__ __forceinline__ unsigned xb_ld(unsigned* p)              { return __hip_atomic_load(p, __ATOMIC_RELAXED, __HIP_MEMORY_SCOPE_AGENT); }
__device__ __forceinline__ unsigned xb_add(unsigned* p, unsigned v) { return __hip_atomic_fetch_add(p, v, __ATOMIC_RELAXED, __HIP_MEMORY_SCOPE_AGENT); }
__device__ __forceinline__ unsigned xb_xcc_id() { return (unsigned)__builtin_amdgcn_s_getreg((3 << 11) | 20) & 0xFu; }
#define XB_SPIN(cond, bar) do { unsigned _sp = 0; while (cond) { __builtin_amdgcn_s_sleep(1); \
    if ((++_sp & 255u) == 0u) { if (xb_ld(&(bar)[XB_TMO])) break; if (_sp > XB_SPIN_CAP) { atomicAdd(&(bar)[XB_TMO], 1u); break; } } } } while (0)

struct XcdBarrier {
    unsigned* bar; unsigned x;
    volatile LAS unsigned* st;
};

__device__ __forceinline__ XcdBarrier xcd_barrier_post(unsigned* bar, volatile LAS unsigned* st) {
    XcdBarrier b; b.bar = bar; b.x = xb_xcc_id(); b.st = st;
    if (threadIdx.x == 0) (void)xb_add(&bar[XB_XCNT(b.x)], 1u);
    return b;
}
__device__ __forceinline__ void xcd_barrier_complete(unsigned* bar, unsigned x, unsigned& nloc, unsigned& nx) {
    const unsigned G = gridDim.x * gridDim.y * gridDim.z;
    unsigned sum, cnt, mine, sp = 0u;
    for (;;) {
        sum = 0u; cnt = 0u; mine = 0u;
#pragma unroll
        for (unsigned j = 0; j < 16; ++j) { const unsigned c = xb_ld(&bar[XB_XCNT(j)]); sum += c; cnt += (c > 0u) ? 1u : 0u; mine = (j == x) ? c : mine; }
        if (sum == G) break;
        __builtin_amdgcn_s_sleep(1);
        if ((++sp & 255u) == 0u) { if (xb_ld(&bar[XB_TMO])) break; if (sp > XB_SPIN_CAP) { atomicAdd(&bar[XB_TMO], 1u); break; } }
    }
    nloc = mine > 0u ? mine : 1u; nx = cnt > 0u ? cnt : 1u;
}

__device__ __forceinline__ void xcd_barrier(const XcdBarrier& b) {
    asm volatile("s_waitcnt vmcnt(0)" ::: "memory");
    __syncthreads();
    if (threadIdx.x == 0) {
        unsigned* bar = b.bar;
        __builtin_amdgcn_s_waitcnt(0);
        unsigned nloc = b.st[0], nx = b.st[1];
        if (nloc == 0u) { xcd_barrier_complete(bar, b.x, nloc, nx); b.st[0] = nloc; b.st[1] = nx; }
        const unsigned old = xb_add(&bar[XB_XSUB(b.x)], 1u);
        const unsigned gen = old / nloc;
        if (old + 1u == (gen + 1u) * nloc) {
            __builtin_amdgcn_fence(__ATOMIC_RELEASE, "agent");
            asm volatile("s_waitcnt vmcnt(0)" ::: "memory");
            const unsigned og = xb_add(&bar[XB_TOP], 1u);
            const unsigned tg = og / nx;
            if (og + 1u == (tg + 1u) * nx) xb_add(&bar[XB_TOPGEN], 1u);
            else XB_SPIN(xb_ld(&bar[XB_TOPGEN]) == tg, bar);
            __builtin_amdgcn_fence(__ATOMIC_ACQUIRE, "agent");
            xb_add(&bar[XB_XGEN(b.x)], 1u);
            asm volatile("s_waitcnt vmcnt(0)" ::: "memory");
        } else {
            XB_SPIN(xb_ld(&bar[XB_XGEN(b.x)]) == gen, bar);
            __builtin_amdgcn_fence(__ATOMIC_ACQUIRE, "agent");
            asm volatile("s_waitcnt vmcnt(0)" ::: "memory");
        }
    }
    __syncthreads();
}

#define GB_CNT(g)  (4096 + 64 * (g))
#define XG_CNT(x)  (6144 + 64 * (x))
#define GB_SPLIT(i) (6656 + 64 * (i))
#define GB_XID(c)  (6912 + (c))
struct GrpBarrier { unsigned* bar; unsigned cnt, n; volatile LAS unsigned* fastw; };
__device__ __forceinline__ void grp_barrier(const GrpBarrier& b, unsigned epoch) {
    asm volatile("s_waitcnt vmcnt(0)" ::: "memory");
    __syncthreads();
    if (threadIdx.x == 0) {
        unsigned* bar = b.bar;
        __builtin_amdgcn_s_waitcnt(0);
        if (*b.fastw != 2u) { __builtin_amdgcn_fence(__ATOMIC_RELEASE, "agent"); asm volatile("s_waitcnt vmcnt(0)" ::: "memory"); }
        (void)xb_add(&bar[b.cnt], 1u);
        const unsigned target = b.n * epoch;
        XB_SPIN(xb_ld(&bar[b.cnt]) < target, bar);
        __builtin_amdgcn_fence(__ATOMIC_ACQUIRE, "agent");
        asm volatile("s_waitcnt vmcnt(0)" ::: "memory");
    }
    __syncthreads();
}
__device__ __forceinline__ void split_arrive(unsigned* bar, int i) { if (threadIdx.x == 0) (void)xb_add(&bar[GB_SPLIT(i)], 1u); }
__device__ __forceinline__ void split_wait(unsigned* bar, int i, unsigned G) { if (threadIdx.x == 0) { XB_SPIN(xb_ld(&bar[GB_SPLIT(i)]) < G, bar); } __syncthreads(); }
template <int MODE  >
DI void transpose_item(const float* W, int K, int N, bf16* WT, int row_off, LAS float* scr, int item, int lane) {
    const int nblk = (N + 31) / 32, kb = item / nblk, nb = item % nblk, k0 = 64 * kb, n0 = 32 * nb;
    const int nn = n0 + (lane & 31);
    float tv[32];
#pragma unroll
    for (int i = 0; i < 32; ++i) { const int kk = 2 * i + (lane >> 5); tv[i] = (nn < N) ? W[(size_t)(k0 + kk) * N + nn] : 0.f; }
    __builtin_amdgcn_sched_barrier(0);
#pragma unroll
    for (int i = 0; i < 32; ++i) { const int kk = 2 * i + (lane >> 5); scr[kk * 33 + (lane & 31)] = tv[i]; }
    asm volatile("s_waitcnt lgkmcnt(0)" ::: "memory");
    const int c = lane & 7;
#pragma unroll
    for (int j = 0; j < 4; ++j) { const int n = (lane >> 3) + 8 * j; const LAS float* s = scr + (8 * c) * 33 + n;
        u32x4 o; o.x = pk2(s[0 * 33], s[1 * 33]); o.y = pk2(s[2 * 33], s[3 * 33]); o.z = pk2(s[4 * 33], s[5 * 33]); o.w = pk2(s[6 * 33], s[7 * 33]);
        const int ng = n0 + n;
        int dr;
        if (MODE == 0) dr = row_off + ng; else if (MODE == 1) dr = (ng >> 7) * 256 + (ng & 127); else dr = (ng >> 7) * 256 + 128 + (ng & 127);
        if (ng < N) *(u32x4*)(WT + (size_t)dr * K + k0 + 8 * c) = o; }
    asm volatile("s_waitcnt lgkmcnt(0)" ::: "memory");
}

DI void p0_adaln_item(Frame& F, int it) {
    const int l = it / 96, n0 = 64 * (it % 96);
    const float* c = F.in[1]; const float* W = F.in[l ? 26 : 4]; const float* bias = F.in[l ? 27 : 5];
    float* MOD = (float*)(F.ws + (l ? WS_MOD1 : WS_MOD0));
    LAS float* sc = (LAS float*)F.lds;
    LAS float* red = (LAS float*)(F.lds + 66048);
    {
        float cv[32];
#pragma unroll
        for (int i = 0; i < 32; ++i) cv[i] = c[F.tid + i * NTHR];
        __builtin_amdgcn_sched_barrier(0);
#pragma unroll
        for (int i = 0; i < 32; ++i) { const int e = F.tid + i * NTHR, b = e >> 10, k = e & 1023; sc[b * 1028 + k] = cv[i] * sigmoidf_(cv[i]); }
    }
    __syncthreads();
    const int lane = F.lane, w = F.wave, cb = w & 1, kq = w >> 1, r32 = lane & 31, hi = lane >> 5;
    f32x16 acc;
#pragma unroll
    for (int r = 0; r < 16; ++r) acc[r] = 0.f;
    const float* wp = W + (size_t)(kq * 256 + hi) * 6144 + n0 + cb * 32 + r32;
    const LAS float* ap = sc + (r32 & 15) * 1028 + kq * 256 + hi;
#pragma unroll 1
    for (int h2 = 0; h2 < 2; ++h2) {
        float wv[64];
#pragma unroll
        for (int s2 = 0; s2 < 64; ++s2) wv[s2] = wp[(size_t)(2 * (64 * h2 + s2)) * 6144];
        __builtin_amdgcn_sched_barrier(0);
#pragma unroll
        for (int s2 = 0; s2 < 64; ++s2) acc = __builtin_amdgcn_mfma_f32_32x32x2f32(ap[2 * (64 * h2 + s2)], wv[s2], acc, 0, 0, 0);
    }
#pragma unroll
    for (int r = 0; r < 8; ++r) red[((kq * 2 + cb) * 8 + r) * 64 + lane] = acc[r];
    __syncthreads();
    if (kq == 0) {
#pragma unroll
        for (int r = 0; r < 8; ++r) { float v = 0.f;
#pragma unroll
            for (int q = 0; q < 4; ++q) v += red[((q * 2 + cb) * 8 + r) * 64 + lane];
            const int b = crow(r, hi), n = n0 + cb * 32 + r32;
            MOD[b * 6144 + n] = v + bias[n]; }
    }
    __syncthreads();
}
DI void p0_cb1_item(Frame& F, int it) {
    const int kv = it >> 1, n0 = 64 * (it & 1);
    const float* pe = F.in[kv ? 17 : 14]; const float* W = F.in[kv ? 18 : 15];
    float* CB1 = (float*)(F.ws + WS_CB1);
    LAS float* red = (LAS float*)F.lds;
    const int col = F.tid & 63, kg = F.tid >> 6;
    float acc = 0.f;
#pragma unroll 1
    for (int k0 = kg * 256; k0 < kg * 256 + 256; k0 += 64) {
        float wv[64];
#pragma unroll
        for (int i = 0; i < 64; ++i) wv[i] = W[(size_t)(k0 + i) * 128 + n0 + col];
        __builtin_amdgcn_sched_barrier(0);
#pragma unroll
        for (int i = 0; i < 64; ++i) acc += pe[k0 + i] * wv[i];
    }
    red[kg * 64 + col] = acc;
    __syncthreads();
    if (F.tid < 64) { float s = 0.f;
#pragma unroll
        for (int g = 0; g < 8; ++g) s += red[g * 64 + F.tid];
        CB1[kv * 128 + n0 + F.tid] = s; }
    __syncthreads();
}
DI void p0_prologue(Frame& F) {
    for (int it = F.bid; it < 196; it += F.G) { if (it < 192) p0_adaln_item(F, it); else p0_cb1_item(F, it - 192); }
    __syncthreads();
    LAS float* scr = (LAS float*)(F.lds + F.wave * 16384);
    const int gw = F.bid * NWV + F.wave, NGW = F.G * NWV;
    unsigned char* ws = F.ws;
    constexpr int I_WIN0 = 16 * 73, I_SQ = 16 * 32, I_FF = 16 * 88, I_WD = 44 * 32, I_WIN1 = 16 * 59, I_C1 = 32 * 4, I_C2 = 2 * 2, I_LR = 8 * 2;
    constexpr int NITEMS = I_WIN0 + I_SQ + 2 * I_FF + I_WD + I_WIN1 + I_SQ + 2 * I_FF + I_WD + 2 * I_C1 + 2 * I_C2 + 2 * I_LR;
    for (int it = gw; it < NITEMS; it += NGW) {
        int r = it;
        if (r < I_WIN0) { transpose_item<0>(F.in[6], 1024, IN0, (bf16*)(ws + WS_WIN0), 0, scr, r, F.lane); continue; } r -= I_WIN0;
        if (r < I_SQ) { transpose_item<0>(F.in[20], 1024, 1024, (bf16*)(ws + WS_WOUT0), 0, scr, r, F.lane); continue; } r -= I_SQ;
        if (r < I_FF) { transpose_item<1>(F.in[21], 1024, DFF, (bf16*)(ws + WS_WGU0), 0, scr, r, F.lane); continue; } r -= I_FF;
        if (r < I_FF) { transpose_item<2>(F.in[22], 1024, DFF, (bf16*)(ws + WS_WGU0), 0, scr, r, F.lane); continue; } r -= I_FF;
        if (r < I_WD) { transpose_item<0>(F.in[23], DFF, 1024, (bf16*)(ws + WS_WD0), 0, scr, r, F.lane); continue; } r -= I_WD;
        if (r < I_WIN1) { transpose_item<0>(F.in[28], 1024, IN1, (bf16*)(ws + WS_WIN1), 0, scr, r, F.lane); continue; } r -= I_WIN1;
        if (r < I_SQ) { transpose_item<0>(F.in[29], 1024, 1024, (bf16*)(ws + WS_WOUT1), 0, scr, r, F.lane); continue; } r -= I_SQ;
        if (r < I_FF) { transpose_item<1>(F.in[30], 1024, DFF, (bf16*)(ws + WS_WGU1), 0, scr, r, F.lane); continue; } r -= I_FF;
        if (r < I_FF) { transpose_item<2>(F.in[31], 1024, DFF, (bf16*)(ws + WS_WGU1), 0, scr, r, F.lane); continue; } r -= I_FF;
        if (r < I_WD) { transpose_item<0>(F.in[32], DFF, 1024, (bf16*)(ws + WS_WD1), 0, scr, r, F.lane); continue; } r -= I_WD;
        if (r < I_C1) { transpose_item<0>(F.in[15], 2048, 128, (bf16*)(ws + WS_CW1K), 0, scr, r, F.lane); continue; } r -= I_C1;
        if (r < I_C1) { transpose_item<0>(F.in[18], 2048, 128, (bf16*)(ws + WS_CW1V), 0, scr, r, F.lane); continue; } r -= I_C1;
        if (r < I_C2) { transpose_item<0>(F.in[16], 128, 64, (bf16*)(ws + WS_CW2K), 0, scr, r, F.lane); continue; } r -= I_C2;
        if (r < I_C2) { transpose_item<0>(F.in[19], 128, 64, (bf16*)(ws + WS_CW2V), 0, scr, r, F.lane); continue; } r -= I_C2;
        if (r < I_LR) { const int h = r >> 1; transpose_item<0>(F.in[9] + h * 4096, 64, 64, (bf16*)(ws + WS_WAT), h * 64, scr, r & 1, F.lane); continue; } r -= I_LR;
        { const int h = r >> 1; transpose_item<0>(F.in[11] + h * 4096, 64, 64, (bf16*)(ws + WS_WXT), h * 64, scr, r & 1, F.lane); }
    }
    {
        const int gt = F.bid * NTHR + F.tid, NGT = F.G * NTHR;
        u32x4* z0 = (u32x4*)(ws + WS_WIN0 + (size_t)IN0 * 1024 * 2); const int n0 = (IN0P - IN0) * 1024 * 2 / 16;
        for (int i = gt; i < n0; i += NGT) z0[i] = (u32x4){0u, 0u, 0u, 0u};
        u32x4* z1 = (u32x4*)(ws + WS_WIN1 + (size_t)IN1 * 1024 * 2); const int n1 = (IN1P - IN1) * 1024 * 2 / 16;
        for (int i = gt; i < n1; i += NGT) z1[i] = (u32x4){0u, 0u, 0u, 0u};
    }
}

DI void norm_mod_phase(Frame& F, const float* X, const float* g, const float* shift, const float* scale, bf16* XN, int r0, int nr) {
    constexpr int R = 8;
    for (int m0 = r0 + F.wave * R; m0 < r0 + nr; m0 += NWV * R) {
        const int b = m0 >> 11;
        f32x4 v[R][4];
#pragma unroll
        for (int r = 0; r < R; ++r) { const f32x4* xr = (const f32x4*)(X + (size_t)(m0 + r) * DM) + F.lane;
#pragma unroll
            for (int j = 0; j < 4; ++j) v[r][j] = xr[64 * j]; }
        f32x4 gg[4], sh[4];
#pragma unroll
        for (int j = 0; j < 4; ++j) { gg[j] = ((const f32x4*)g)[F.lane + 64 * j] * (((const f32x4*)(scale + (size_t)b * 6144))[F.lane + 64 * j] + 1.0f); sh[j] = ((const f32x4*)(shift + (size_t)b * 6144))[F.lane + 64 * j]; }
        __builtin_amdgcn_sched_barrier(0);
#pragma unroll
        for (int r = 0; r < R; ++r) {
            float s = 0.f;
#pragma unroll
            for (int j = 0; j < 4; ++j) s += (v[r][j].x * v[r][j].x + v[r][j].y * v[r][j].y) + (v[r][j].z * v[r][j].z + v[r][j].w * v[r][j].w);
            const float rstd = __builtin_amdgcn_rsqf(wave_sum(s) * (1.f / DM) + 1e-6f);
            u32x2* o8 = (u32x2*)(XN + (size_t)(m0 + r) * DM) + F.lane;
#pragma unroll
            for (int j = 0; j < 4; ++j) { const f32x4 y = v[r][j] * rstd * gg[j] + sh[j]; u32x2 w; w.x = pk2(y[0], y[1]); w.y = pk2(y[2], y[3]); o8[64 * j] = w; }
        }
    }
}
DI void norm_mod_phase16(Frame& F, const bf16* X, const float* g, const float* shift, const float* scale, bf16* XN, int r0, int nr) {
    for (int m0 = r0 + F.wave * 4; m0 < r0 + nr; m0 += NWV * 4) {
        const int b = m0 >> 11;
        u32x4 u[4][2];
#pragma unroll
        for (int r = 0; r < 4; ++r) { const u32x4* xr = (const u32x4*)(X + (size_t)(m0 + r) * DM) + F.lane; u[r][0] = xr[0]; u[r][1] = xr[64]; }
        f32x4 gg[4], sc[4], sh[4];
#pragma unroll
        for (int q = 0; q < 4; ++q) { const int c0 = 512 * (q >> 1) + 8 * F.lane + 4 * (q & 1); gg[q] = *(const f32x4*)(g + c0); sc[q] = *(const f32x4*)(scale + (size_t)b * 6144 + c0); sh[q] = *(const f32x4*)(shift + (size_t)b * 6144 + c0); }
#pragma unroll
        for (int q = 0; q < 4; ++q) gg[q] = gg[q] * (sc[q] + 1.0f);
#pragma unroll
        for (int r = 0; r < 4; ++r) {
            float v[16]; float s = 0.f;
#pragma unroll
            for (int j = 0; j < 2; ++j)
#pragma unroll
                for (int e = 0; e < 4; ++e) { v[8 * j + 2 * e] = __uint_as_float(u[r][j][e] << 16); v[8 * j + 2 * e + 1] = __uint_as_float(u[r][j][e] & 0xffff0000u); }
#pragma unroll
            for (int e = 0; e < 16; ++e) s += v[e] * v[e];
            const float rstd = __builtin_amdgcn_rsqf(wave_sum(s) * (1.f / DM) + 1e-6f);
            u32x4* o8 = (u32x4*)(XN + (size_t)(m0 + r) * DM) + F.lane;
#pragma unroll
            for (int j = 0; j < 2; ++j) {
                float y[8];
#pragma unroll
                for (int q = 0; q < 2; ++q)
#pragma unroll
                    for (int e = 0; e < 4; ++e) y[4 * q + e] = v[8 * j + 4 * q + e] * rstd * gg[2 * j + q][e] + sh[2 * j + q][e];
                u32x4 w; w.x = pk2(y[0], y[1]); w.y = pk2(y[2], y[3]); w.z = pk2(y[4], y[5]); w.w = pk2(y[6], y[7]); o8[64 * j] = w;
            }
        }
    }
}
DI void final_norm_phase16(Frame& F, const bf16* X, float* out, const float* g, int r0, int nr) {
    f32x4 gg[4];
#pragma unroll
    for (int q = 0; q < 4; ++q) gg[q] = *(const f32x4*)(g + 512 * (q >> 1) + 8 * F.lane + 4 * (q & 1));
    for (int m0 = r0 + F.wave * 4; m0 < r0 + nr; m0 += NWV * 4) {
        u32x4 u[4][2];
#pragma unroll
        for (int r = 0; r < 4; ++r) { const u32x4* xr = (const u32x4*)(X + (size_t)(m0 + r) * DM) + F.lane; u[r][0] = xr[0]; u[r][1] = xr[64]; }
#pragma unroll
        for (int r = 0; r < 4; ++r) {
            float v[16]; float s = 0.f;
#pragma unroll
            for (int j = 0; j < 2; ++j)
#pragma unroll
                for (int e = 0; e < 4; ++e) { v[8 * j + 2 * e] = __uint_as_float(u[r][j][e] << 16); v[8 * j + 2 * e + 1] = __uint_as_float(u[r][j][e] & 0xffff0000u); }
#pragma unroll
            for (int e = 0; e < 16; ++e) s += v[e] * v[e];
            const float rstd = __builtin_amdgcn_rsqf(wave_sum(s) * (1.f / DM) + 1e-6f);
#pragma unroll
            for (int q = 0; q < 4; ++q) { f32x4 o;
#pragma unroll
                for (int e = 0; e < 4; ++e) o[e] = v[4 * q + e] * rstd * gg[q][e];
                *(f32x4*)(out + (size_t)(m0 + r) * DM + 512 * (q >> 1) + 8 * F.lane + 4 * (q & 1)) = o; }
        }
    }
}
DI void final_norm_phase(Frame& F, float* X, const float* g) {
    const int gw = F.bid * NWV + F.wave, NGW = F.G * NWV;
    for (int m = gw; m < MROWS; m += NGW) {
        f32x4* xr = (f32x4*)(X + (size_t)m * DM) + F.lane;
        f32x4 v[4]; float s = 0.f;
#pragma unroll
        for (int j = 0; j < 4; ++j) { v[j] = xr[64 * j]; s += (v[j].x * v[j].x + v[j].y * v[j].y) + (v[j].z * v[j].z + v[j].w * v[j].w); }
        const float rstd = __builtin_amdgcn_rsqf(wave_sum(s) * (1.f / DM) + 1e-6f);
#pragma unroll
        for (int j = 0; j < 4; ++j) { const f32x4 gg = ((const f32x4*)g)[F.lane + 64 * j]; xr[64 * j] = v[j] * rstd * gg; }
    }
}

DI void lru_stage1_item(Frame& F, int item) {
    const int b = item >> 7, h = (item >> 4) & 7, ck = item & 15, t0 = ck * 128;
    const int tid = opaque(F.tid), lane = tid & 63, w = F.wave, r32 = lane & 31, hi = lane >> 5;
    LAS bf16* XCB = (LAS bf16*)F.lds;
    LAS float* XCF = (LAS float*)(F.lds + 18432);
    LAS float* AL = (LAS float*)(F.lds + 18432 + 32768);
    LAS float* UL = (LAS float*)(F.lds + 18432 + 65536);
    LAS float* TOT = (LAS float*)(F.lds + 18432 + 98304);
    LAS bf16* AXT = (LAS bf16*)(F.lds + 18432 + 98304 + 4096);
    const bf16* P1 = (const bf16*)(F.ws + WS_BIG);
    const int tb = w >> 1, cb2 = w & 1;
    bf16x8 wa_f[4], wx_f[4];
    {
        const bf16* WAT = (const bf16*)(F.ws + WS_WAT) + (size_t)(h * 64 + cb2 * 32 + r32) * 64 + hi * 8;
        const bf16* WXT = (const bf16*)(F.ws + WS_WXT) + (size_t)(h * 64 + cb2 * 32 + r32) * 64 + hi * 8;
#pragma unroll
        for (int ks = 0; ks < 4; ++ks) { wa_f[ks] = *(const bf16x8*)(WAT + ks * 16); wx_f[ks] = *(const bf16x8*)(WXT + ks * 16); }
    }
    {
        const bf16* ax = P1 + (size_t)(b * SEQ) * BIGP + C_AX + h * 64;
        const int ch8 = tid & 7;
        u32x4 v[3];
#pragma unroll
        for (int p = 0; p < 3; ++p) { const int rr = (tid >> 3) + 64 * p, t = t0 - 3 + rr; v[p] = (u32x4){0u, 0u, 0u, 0u}; if (rr < 131 && t >= 0) v[p] = *(const u32x4*)(ax + (size_t)t * BIGP + ch8 * 8); }
#pragma unroll
        for (int p = 0; p < 3; ++p) { const int rr = (tid >> 3) + 64 * p; if (rr < 131) *(LAS u32x4*)(AXT + rr * 64 + ch8 * 8) = v[p]; }
    }
    __syncthreads();
    {
        const int c = tid & 63, tg = tid >> 6, ch = h * 64 + c;
        const float* cw = F.in[7]; const float w0 = cw[ch], w1 = cw[512 + ch], w2 = cw[1024 + ch], w3 = cw[1536 + ch], cb = F.in[8][ch];
        float x3 = bf2f(AXT[(tg * 16 + 0) * 64 + c]), x2 = bf2f(AXT[(tg * 16 + 1) * 64 + c]), x1 = bf2f(AXT[(tg * 16 + 2) * 64 + c]);
#pragma unroll 8
        for (int i = 0; i < 16; ++i) {
            const float x0 = bf2f(AXT[(tg * 16 + i + 3) * 64 + c]);
            const float v = w0 * x3 + w1 * x2 + w2 * x1 + w3 * x0 + cb;
            XCF[(tg * 16 + i) * 64 + c] = v; XCB[(tg * 16 + i) * 72 + c] = f2bf(v);
            x3 = x2; x2 = x1; x1 = x0;
        }
    }
    __syncthreads();
    {
        f32x16 accA, accX;
#pragma unroll
        for (int r = 0; r < 16; ++r) { accA[r] = 0.f; accX[r] = 0.f; }
#pragma unroll
        for (int ks = 0; ks < 4; ++ks) {
            const bf16x8 a = *(const LAS bf16x8*)(XCB + (tb * 32 + r32) * 72 + ks * 16 + hi * 8);
            accA = MFMA32(a, wa_f[ks], accA); accX = MFMA32(a, wx_f[ks], accX);
        }
        const int j = cb2 * 32 + r32, chj = h * 64 + j;
        const float ba_ = F.in[10][chj], bx_ = F.in[12][chj];
        const float sp = log1pf(__expf(-F.in[13][chj]));
#pragma unroll
        for (int r = 0; r < 16; ++r) {
            const int tok = tb * 32 + crow(r, hi);
            const float rg = sigmoidf_(accA[r] + ba_), ig = sigmoidf_(accX[r] + bx_);
            const float a = __expf(-8.0f * rg * sp);
            float mult = __builtin_amdgcn_sqrtf(fmaxf(1.0f - a * a, 0.f));
            if (t0 + tok == 0) mult = 1.0f;
            AL[tok * 64 + j] = a; UL[tok * 64 + j] = mult * ig * XCF[tok * 64 + j];
        }
    }
    __syncthreads();
    {
        const int c = tid & 63, tg = tid >> 6, ch = h * 64 + c;
        float P = 1.f, hh = 0.f;
#pragma unroll 8
        for (int i = 0; i < 16; ++i) { const int o = (tg * 16 + i) * 64 + c; const float a = AL[o], u = UL[o]; hh = a * hh + u; P *= a; UL[o] = hh; AL[o] = P; }
        TOT[(tg * 64 + c) * 2] = P; TOT[(tg * 64 + c) * 2 + 1] = hh;
        __syncthreads();
        float Pc = 1.f, hc = 0.f;
        for (int s = 0; s < tg; ++s) { const float p = TOT[(s * 64 + c) * 2], q = TOT[(s * 64 + c) * 2 + 1]; hc = p * hc + q; Pc *= p; }
        bf16* HL = (bf16*)(F.ws + WS_HL); bf16* PCm = (bf16*)(F.ws + WS_PC);
#pragma unroll 8
        for (int i = 0; i < 16; ++i) { const int o = (tg * 16 + i) * 64 + c; const size_t go = (size_t)(b * SEQ + t0 + tg * 16 + i) * 512 + ch;
            HL[go] = f2bf(UL[o] + AL[o] * hc); PCm[go] = f2bf(AL[o] * Pc); }
    }
    __syncthreads();
}
DI void lru_stage2_item(Frame& F, int item) {
    const int b = item >> 4, ck = item & 15, tid = opaque(F.tid), cq = tid & 127, tg = tid >> 7;
    const bf16* HL = (const bf16*)(F.ws + WS_HL); const bf16* PCm = (const bf16*)(F.ws + WS_PC);
    const bf16* P1 = (const bf16*)(F.ws + WS_BIG); bf16* Y = (bf16*)(F.ws + WS_Y);
    u32x2 pv[15], qv[15];
#pragma unroll
    for (int j = 0; j < 15; ++j) { const size_t ro = (size_t)(b * SEQ + (j < ck ? j : 0) * 128 + 127) * 512 + cq * 4; pv[j] = *(const u32x2*)(PCm + ro); qv[j] = *(const u32x2*)(HL + ro); }
    float hc[4] = {0.f, 0.f, 0.f, 0.f};
#pragma unroll
    for (int j = 0; j < 15; ++j) {
        const bool on = j < ck;
        const float p0 = on ? __uint_as_float(pv[j].x << 16) : 1.f, p1 = on ? __uint_as_float(pv[j].x & 0xffff0000u) : 1.f, p2 = on ? __uint_as_float(pv[j].y << 16) : 1.f, p3 = on ? __uint_as_float(pv[j].y & 0xffff0000u) : 1.f;
        const float q0 = on ? __uint_as_float(qv[j].x << 16) : 0.f, q1 = on ? __uint_as_float(qv[j].x & 0xffff0000u) : 0.f, q2 = on ? __uint_as_float(qv[j].y << 16) : 0.f, q3 = on ? __uint_as_float(qv[j].y & 0xffff0000u) : 0.f;
        hc[0] = p0 * hc[0] + q0; hc[1] = p1 * hc[1] + q1; hc[2] = p2 * hc[2] + q2; hc[3] = p3 * hc[3] + q3;
    }
    const size_t row0 = (size_t)(b * SEQ + ck * 128 + tg * 32);
#pragma unroll 8
    for (int i = 0; i < 32; ++i) {
        const size_t row = row0 + i;
        const u32x2 hv = *(const u32x2*)(HL + row * 512 + cq * 4), pc = *(const u32x2*)(PCm + row * 512 + cq * 4), ag = *(const u32x2*)(P1 + row * BIGP + C_AGATE + cq * 4);
        const float h0 = __uint_as_float(hv.x << 16) + __uint_as_float(pc.x << 16) * hc[0], h1 = __uint_as_float(hv.x & 0xffff0000u) + __uint_as_float(pc.x & 0xffff0000u) * hc[1];
        const float h2 = __uint_as_float(hv.y << 16) + __uint_as_float(pc.y << 16) * hc[2], h3 = __uint_as_float(hv.y & 0xffff0000u) + __uint_as_float(pc.y & 0xffff0000u) * hc[3];
        u32x2 o; o.x = pk2(h0 * gelu_tanh(__uint_as_float(ag.x << 16)), h1 * gelu_tanh(__uint_as_float(ag.x & 0xffff0000u)));
        o.y = pk2(h2 * gelu_tanh(__uint_as_float(ag.y << 16)), h3 * gelu_tanh(__uint_as_float(ag.y & 0xffff0000u)));
        *(u32x2*)(Y + row * DM + cq * 4) = o;
    }
}

DI void lru_fused_item(Frame& F, int item) {
    const int b = item >> 4, h = (item >> 1) & 7, cb = item & 1;
    const int tid = opaque(F.tid), lane = tid & 63, w = F.wave, r32 = lane & 31, hi = lane >> 5;
    LAS bf16* AXT = (LAS bf16*)F.lds;
    LAS bf16* AGT = (LAS bf16*)(F.lds + 33536);
    LAS bf16* XCB = (LAS bf16*)(F.lds + 58112);
    LAS bf16* GP = (LAS bf16*)(F.lds + 94976);
    LAS float* TOT = (LAS float*)(F.lds + 129792);
    LAS float* CAR = (LAS float*)(F.lds + 133888);
    const bf16* P1 = (const bf16*)(F.ws + WS_BIG);
    bf16* Y = (bf16*)(F.ws + WS_Y);
    const int tb = w >> 1, gsel = w & 1;
    bf16x8 wf[4];
    {
        const bf16* WT = (const bf16*)(F.ws + (gsel ? WS_WXT : WS_WAT)) + (size_t)(h * 64 + cb * 32 + r32) * 64 + hi * 8;
#pragma unroll
        for (int ks = 0; ks < 4; ++ks) wf[ks] = *(const bf16x8*)(WT + ks * 16);
    }
    const int c4 = tid & 15, tq = tid >> 4;
    const float* cw = F.in[7];
    float cw0[4], cw1[4], cw2[4], cw3[4], cbs[4];
#pragma unroll
    for (int e = 0; e < 4; ++e) { const int chc = h * 64 + 4 * c4 + e; cw0[e] = cw[chc]; cw1[e] = cw[512 + chc]; cw2[e] = cw[1024 + chc]; cw3[e] = cw[1536 + chc]; cbs[e] = F.in[8][chc]; }
    const int j = tid & 31, tgp = tid >> 5, chj = h * 64 + cb * 32 + j;
    const float ba_ = F.in[10][chj], bx_ = F.in[12][chj];
    const float sp8 = -8.0f * log1pf(__expf(-F.in[13][chj]));
    const bf16* ax = P1 + (size_t)(b * SEQ) * BIGP + C_AX + h * 64;
    const bf16* ag = P1 + (size_t)(b * SEQ) * BIGP + C_AGATE + h * 64 + cb * 32;
    const int ch8 = tid & 7, row8 = tid >> 3;
    u32x4 pax[3], pag;
#define LRU_PREFETCH(CK) do { const int ck_ = (CK) < 16 ? (CK) : 15; const int t0_ = ck_ * 128; \
        _Pragma("unroll") for (int p = 0; p < 3; ++p) { const int rr = row8 + 64 * p, t = t0_ - 3 + rr; pax[p] = (u32x4){0u, 0u, 0u, 0u}; if (rr < 131 && t >= 0) pax[p] = *(const u32x4*)(ax + (size_t)t * BIGP + ch8 * 8); } \
        pag = *(const u32x4*)(ag + (size_t)(t0_ + (tid >> 2)) * BIGP + (tid & 3) * 8); } while (0)
#define LRU_STORE(CK) do { LAS bf16* axt_ = AXT + ((CK) & 1) * (131 * 64); LAS bf16* agt_ = AGT + ((CK) % 3) * (128 * 32); \
        _Pragma("unroll") for (int p = 0; p < 3; ++p) { const int rr = row8 + 64 * p; if (rr < 131) *(LAS u32x4*)(axt_ + rr * 64 + ch8 * 8) = pax[p]; } \
        *(LAS u32x4*)(agt_ + (tid >> 2) * 32 + (tid & 3) * 8) = pag; } while (0)
#define LRU_BF(U, E) __uint_as_float(((E) & 1) ? ((U)[(E) >> 1] & 0xffff0000u) : ((U)[(E) >> 1] << 16))
#define LRU_CONV(CK) do { const LAS bf16* axt_ = AXT + ((CK) & 1) * (131 * 64); LAS bf16* xcb_ = XCB + ((CK) & 1) * (128 * 72); \
        u32x2 xr_[7]; _Pragma("unroll") for (int p_ = 0; p_ < 7; ++p_) xr_[p_] = *(const LAS u32x2*)(axt_ + (4 * tq + p_) * 64 + 4 * c4); \
        _Pragma("unroll") for (int i = 0; i < 4; ++i) { float o_[4]; \
            _Pragma("unroll") for (int e = 0; e < 4; ++e) o_[e] = cw0[e] * LRU_BF(xr_[i], e) + cw1[e] * LRU_BF(xr_[i + 1], e) + cw2[e] * LRU_BF(xr_[i + 2], e) + cw3[e] * LRU_BF(xr_[i + 3], e) + cbs[e]; \
            u32x2 w_; w_.x = pk2(o_[0], o_[1]); w_.y = pk2(o_[2], o_[3]); *(LAS u32x2*)(xcb_ + (4 * tq + i) * 72 + 4 * c4) = w_; } } while (0)
#define LRU_GEMM(CK) do { const LAS bf16* xcb_ = XCB + ((CK) & 1) * (128 * 72); LAS bf16* gp_ = GP + (((CK) & 1) * 2 + gsel) * (32 * 136); \
        f32x16 acc; _Pragma("unroll") for (int r = 0; r < 16; ++r) acc[r] = 0.f; \
        _Pragma("unroll") for (int ks = 0; ks < 4; ++ks) { const bf16x8 a = *(const LAS bf16x8*)(xcb_ + (tb * 32 + r32) * 72 + ks * 16 + hi * 8); acc = MFMA32(a, wf[ks], acc); } \
        _Pragma("unroll") for (int q_ = 0; q_ < 4; ++q_) { u32x2 w_; w_.x = pk2(acc[4 * q_], acc[4 * q_ + 1]); w_.y = pk2(acc[4 * q_ + 2], acc[4 * q_ + 3]); \
            *(LAS u32x2*)(gp_ + r32 * 136 + tb * 32 + 8 * q_ + 4 * hi) = w_; } } while (0)
    LRU_PREFETCH(0);
    if (tid < 64) CAR[tid] = 0.f;
    __syncthreads();
    LRU_STORE(0); LRU_PREFETCH(1);
    __syncthreads();
    LRU_CONV(0); LRU_STORE(1); LRU_PREFETCH(2);
    __syncthreads();
    LRU_GEMM(0);
    __syncthreads();
    for (int ck = 0; ck < 16; ++ck) {
        const int t0 = ck * 128;
        if (ck + 1 < 16) LRU_CONV(ck + 1);
        float hl[8], pl[8];
        {
            const LAS bf16* gp_ = GP + (ck & 1) * 2 * (32 * 136); const LAS bf16* xcb_ = XCB + (ck & 1) * (128 * 72);
            const u32x4 ga_ = *(const LAS u32x4*)(gp_ + j * 136 + tgp * 8), gx_ = *(const LAS u32x4*)(gp_ + (32 + j) * 136 + tgp * 8);
            float P = 1.f, hh = 0.f;
#pragma unroll
            for (int i = 0; i < 8; ++i) {
                const int tok = tgp * 8 + i;
                const float rg = sigmoidf_(LRU_BF(ga_, i) + ba_), ig = sigmoidf_(LRU_BF(gx_, i) + bx_);
                const float a = __expf(rg * sp8);
                float mult = __builtin_amdgcn_sqrtf(__builtin_amdgcn_fmed3f(1.0f - a * a, 0.f, 2.0f));
                if (t0 + tok == 0) mult = 1.0f;
                hh = a * hh + mult * ig * bf2f(xcb_[tok * 72 + cb * 32 + j]); P *= a;
                hl[i] = hh; pl[i] = P;
            }
            TOT[(tgp * 32 + j) * 2] = P; TOT[(tgp * 32 + j) * 2 + 1] = hh;
        }
        if (ck + 2 < 16) { LRU_STORE(ck + 2); LRU_PREFETCH(ck + 3); }
        lds_barrier();
        if (ck + 1 < 16) LRU_GEMM(ck + 1);
        {
            float hc = CAR[(ck & 1) * 32 + j];
            {
                typedef float f32x2_t __attribute__((ext_vector_type(2)));
                f32x2_t tt[15];
#pragma unroll
                for (int sidx = 0; sidx < 15; ++sidx) tt[sidx] = *(const LAS f32x2_t*)(TOT + (sidx * 32 + j) * 2);
#pragma unroll
                for (int sidx = 0; sidx < 15; ++sidx) { const bool on = sidx < tgp; hc = (on ? tt[sidx].x : 1.f) * hc + (on ? tt[sidx].y : 0.f); }
            }
            const LAS bf16* agt = AGT + (ck % 3) * (128 * 32);
            bf16* yp = Y + (size_t)(b * SEQ + t0 + tgp * 8) * DM + h * 64 + cb * 32 + j;
#pragma unroll
            for (int i = 0; i < 8; ++i) { const float hf = hl[i] + pl[i] * hc; yp[(size_t)i * DM] = f2bf(hf * gelu_tanh(bf2f(agt[(tgp * 8 + i) * 32 + j])));
                if (i == 7 && tgp == 15) CAR[((ck + 1) & 1) * 32 + j] = hf; }
        }
        lds_barrier();
    }
#undef LRU_PREFETCH
#undef LRU_STORE
#undef LRU_CONV
#undef LRU_BF
#undef LRU_GEMM
}

DI void cmp_item(Frame& F, int item) {
    const int kv = item >> 7, rest = item & 127, b = rest >> 3, g = (rest >> 2) & 1, cc = rest & 3;
    const int tid = opaque(F.tid), lane = tid & 63, w = F.wave, r32 = lane & 31, hi = lane >> 5;
    const bf16* P1 = (const bf16*)(F.ws + WS_BIG);
    const bf16* W1T = (const bf16*)(F.ws + (kv ? WS_CW1V : WS_CW1K)); const bf16* W2T = (const bf16*)(F.ws + (kv ? WS_CW2V : WS_CW2K));
    const float* CB1 = (const float*)(F.ws + WS_CB1) + kv * 128;
    bf16* OUT = (bf16*)(F.ws + (kv ? WS_VC : WS_KC));
    constexpr int KP = 272;
    LAS unsigned char* AT = F.lds;
    LAS unsigned char* BT = F.lds + 2 * 32 * KP;
    LAS float* RED = (LAS float*)(F.lds + 2 * 32 * KP + 2 * 128 * KP);
    LAS bf16* HD = (LAS bf16*)(F.lds + 2 * 32 * KP + 2 * 128 * KP + 16384);
    const int nb = w & 3, kq = w >> 2;
    const int lc = tid >> 4, lch = tid & 15;
    const int cg = cc * 32 + lc, cgl = cg < 126 ? cg : 126;
    const bf16* asrc = P1 + (size_t)(b * SEQ + 16 * cgl + (lch >> 3)) * BIGP + (kv ? C_VC : C_KC) + g * 64 + (lch & 7) * 8;
    const bf16* bsrc = W1T + (size_t)lc * 2048 + lch * 8;
    const int lofs = lc * KP + lch * 16;
    bf16x8 w2f[8];
#pragma unroll
    for (int ks = 0; ks < 8; ++ks) w2f[ks] = *(const bf16x8*)(W2T + (size_t)((w & 1) * 32 + r32) * 128 + ks * 16 + hi * 8);
    const float bias1 = CB1[nb * 32 + r32];
    u32x4 pa, pb[4];
#define CM_LD(T) do { const int t_ = (T) < 16 ? (T) : 15; pa = *(const u32x4*)(asrc + (size_t)(2 * t_) * BIGP); \
        _Pragma("unroll") for (int i = 0; i < 4; ++i) pb[i] = *(const u32x4*)(bsrc + (size_t)(32 * i) * 2048 + 128 * t_); } while (0)
#define CM_ST(BUF) do { *(LAS u32x4*)(AT + (BUF) * 32 * KP + lofs) = pa; \
        _Pragma("unroll") for (int i = 0; i < 4; ++i) *(LAS u32x4*)(BT + (BUF) * 128 * KP + i * 32 * KP + lofs) = pb[i]; } while (0)
    CM_LD(0);
    __syncthreads();
    CM_ST(0);
    __syncthreads();
    f32x16 acc;
#pragma unroll
    for (int r = 0; r < 16; ++r) acc[r] = 0.f;
    for (int t = 0; t < 16; ++t) {
        const int buf = t & 1;
        CM_LD(t + 1);
        __builtin_amdgcn_sched_barrier(0);
#pragma unroll
        for (int ks = 0; ks < 4; ++ks) {
            const int kofs = ((kq * 4 + ks) * 16 + hi * 8) * 2;
            const bf16x8 a = *(const LAS bf16x8*)(AT + buf * 32 * KP + r32 * KP + kofs);
            const bf16x8 bw = *(const LAS bf16x8*)(BT + buf * 128 * KP + (nb * 32 + r32) * KP + kofs);
            acc = MFMA32(a, bw, acc);
        }
        CM_ST(buf ^ 1);
        lds_barrier();
    }
#undef CM_LD
#undef CM_ST
    if (kq == 1) {
#pragma unroll
        for (int r = 0; r < 16; ++r) RED[(nb * 16 + r) * 64 + lane] = acc[r];
    }
    __syncthreads();
    if (kq == 0) {
        const int n = nb * 32 + r32; const float bias = bias1;
#pragma unroll
        for (int r = 0; r < 16; ++r) { const float v = acc[r] + RED[(nb * 16 + r) * 64 + lane] + bias; HD[crow(r, hi) * 136 + n] = f2bf(gelu_tanh(v)); }
    }
    __syncthreads();
    if (w < 2) {
        f32x16 a2;
#pragma unroll
        for (int r = 0; r < 16; ++r) a2[r] = 0.f;
#pragma unroll
        for (int ks = 0; ks < 8; ++ks) {
            const bf16x8 a = *(const LAS bf16x8*)(HD + r32 * 136 + ks * 16 + hi * 8);
            a2 = MFMA32(a, w2f[ks], a2);
        }
        const int d = w * 32 + r32;
#pragma unroll
        for (int r = 0; r < 16; ++r) { const int co = cc * 32 + crow(r, hi); OUT[((size_t)(b * 2 + g) * 128 + co) * 64 + d] = (co < 127) ? f2bf(a2[r]) : (bf16)0; }
    }
    __syncthreads();
}

constexpr int TP = 144;
struct AttnState { f32x16 o0, o1, negm, o2; float mref, l; };
constexpr float ATT_THR = 8.0f;
DI void attn_init(AttnState& st) {
#pragma unroll
    for (int r = 0; r < 16; ++r) { st.o0[r] = 0.f; st.o1[r] = 0.f; st.negm[r] = 0.f; st.o2[r] = 0.f; }
    st.mref = 0.f; st.l = 0.f;
}
DI void load_tile(const bf16* g, size_t pitch, LAS unsigned char* dst, int tid) {
    const int key = tid >> 3, ch = tid & 7;
    const u32x4 v = *(const u32x4*)(g + (size_t)key * pitch + ch * 8);
    *(LAS u32x4*)(dst + key * TP + ch * 16) = v;
}
DI f32x16 qk_block(const LAS unsigned char* Kt, int kb, const bf16x8 (&qf)[4], const f32x16& c0, int r32, int hi) {
    f32x16 s;
#pragma unroll
    for (int ks = 0; ks < 4; ++ks) {
        const bf16x8 kf = *(const LAS bf16x8*)(Kt + (kb * 32 + r32) * TP + (ks * 16 + hi * 8) * 2);
        s = (ks == 0) ? MFMA32(kf, qf[0], c0) : MFMA32(kf, qf[ks], s);
    }
    return s;
}
DI void pv_block(const LAS unsigned char* Vt, int kb, const f32x16& p, f32x16& o0, f32x16& o1, int lane) {
    const int hi = lane >> 5, i16 = lane & 15, q = i16 >> 2, pp = i16 & 3, blk = (lane >> 4) & 1;
#pragma unroll
    for (int s2 = 0; s2 < 2; ++s2) {
        u32x4 pw; pw.x = pk2(p[8 * s2 + 0], p[8 * s2 + 1]); pw.y = pk2(p[8 * s2 + 2], p[8 * s2 + 3]); pw.z = pk2(p[8 * s2 + 4], p[8 * s2 + 5]); pw.w = pk2(p[8 * s2 + 6], p[8 * s2 + 7]);
        const bf16x8 pf = __builtin_bit_cast(bf16x8, pw);
        const int rlo = kb * 32 + 16 * s2 + 4 * hi + q, rhi = rlo + 8;
#pragma unroll
        for (int db = 0; db < 2; ++db) {
            const int cbyte = (32 * db + 16 * blk + 4 * pp) * 2;
            const s16x4 lo = vtr((const LAS char*)(Vt + rlo * TP + cbyte));
            const s16x4 hv = vtr((const LAS char*)(Vt + rhi * TP + cbyte));
            const bf16x8 vf = (bf16x8){lo[0], lo[1], lo[2], lo[3], hv[0], hv[1], hv[2], hv[3]};
            if (db == 0) o0 = MFMA32(vf, pf, o0); else o1 = MFMA32(vf, pf, o1);
        }
    }
}
DI void v_frags(const LAS unsigned char* Vt, bf16x8 (&vf)[8], int lane) {
    const int hi = lane >> 5, i16 = lane & 15, q = i16 >> 2, pp = i16 & 3, blk = (lane >> 4) & 1;
#pragma unroll
    for (int kb = 0; kb < 2; ++kb)
#pragma unroll
        for (int s2 = 0; s2 < 2; ++s2) {
            const int rlo = kb * 32 + 16 * s2 + 4 * hi + q, rhi = rlo + 8;
#pragma unroll
            for (int db = 0; db < 2; ++db) {
                const int cbyte = (32 * db + 16 * blk + 4 * pp) * 2;
                const s16x4 lo = vtr((const LAS char*)(Vt + rlo * TP + cbyte));
                const s16x4 hv = vtr((const LAS char*)(Vt + rhi * TP + cbyte));
                vf[(kb * 2 + s2) * 2 + db] = (bf16x8){lo[0], lo[1], lo[2], lo[3], hv[0], hv[1], hv[2], hv[3]};
            }
        }
}
DI void pv_frags(const bf16x8 (&vf)[8], const f32x16 (&p)[2], f32x16& o0, f32x16& o1) {
#pragma unroll
    for (int kb = 0; kb < 2; ++kb)
#pragma unroll
        for (int s2 = 0; s2 < 2; ++s2) {
            u32x4 pw; pw.x = pk2(p[kb][8 * s2 + 0], p[kb][8 * s2 + 1]); pw.y = pk2(p[kb][8 * s2 + 2], p[kb][8 * s2 + 3]); pw.z = pk2(p[kb][8 * s2 + 4], p[kb][8 * s2 + 5]); pw.w = pk2(p[kb][8 * s2 + 6], p[kb][8 * s2 + 7]);
            const bf16x8 pf = __builtin_bit_cast(bf16x8, pw);
            o0 = MFMA32(vf[(kb * 2 + s2) * 2 + 0], pf, o0); o1 = MFMA32(vf[(kb * 2 + s2) * 2 + 1], pf, o1);
        }
}
DI void pv_frags_sum(const bf16x8 (&vf)[8], const f32x16 (&p)[2], f32x16& o0, f32x16& o1, f32x16& o2, int lane) {
    const short one = (lane & 31) == 0 ? (short)0x3f80 : (short)0;
    const bf16x8 vones = (bf16x8){one, one, one, one, one, one, one, one};
#pragma unroll
    for (int kb = 0; kb < 2; ++kb)
#pragma unroll
        for (int s2 = 0; s2 < 2; ++s2) {
            u32x4 pw; pw.x = pk2(p[kb][8 * s2 + 0], p[kb][8 * s2 + 1]); pw.y = pk2(p[kb][8 * s2 + 2], p[kb][8 * s2 + 3]); pw.z = pk2(p[kb][8 * s2 + 4], p[kb][8 * s2 + 5]); pw.w = pk2(p[kb][8 * s2 + 6], p[kb][8 * s2 + 7]);
            const bf16x8 pf = __builtin_bit_cast(bf16x8, pw);
            o0 = MFMA32(vf[(kb * 2 + s2) * 2 + 0], pf, o0); o1 = MFMA32(vf[(kb * 2 + s2) * 2 + 1], pf, o1); o2 = MFMA32(vones, pf, o2);
        }
}
template <int MODE, class MaskF>
DI void attn_softmax_pv(f32x16 (&s)[2], const bf16x8 (&vf)[8], AttnState& st, const MaskF& mask, int lane) {
    const int hi = lane >> 5;
    float mx = -INFINITY;
#pragma unroll
    for (int kb = 0; kb < 2; ++kb)
#pragma unroll
        for (int r = 0; r < 16; ++r) { float v = s[kb][r]; if (MODE == 1) { if (!mask(kb, r)) v = -INFINITY; s[kb][r] = v; } if (MODE == 3) { if (!mask.rowsel()) v = -INFINITY; s[kb][r] = v; } mx = fmaxf(mx, v); }
    mx = max_x32(mx);
    if (__any(mx > ATT_THR)) {
        const float dl = fmaxf(mx, 0.f), f = __builtin_amdgcn_exp2f(-dl);
        st.mref += dl; st.l *= f;
#pragma unroll
        for (int r = 0; r < 16; ++r) { s[0][r] -= dl; s[1][r] -= dl; st.o0[r] *= f; st.o1[r] *= f; st.negm[r] = -st.mref; }
        if (MODE == 2) st.o2[0] *= f;
    }
    float ls = 0.f;
#pragma unroll
    for (int kb = 0; kb < 2; ++kb)
#pragma unroll
        for (int r = 0; r < 16; ++r) { float p = __builtin_amdgcn_exp2f(s[kb][r]); if (MODE == 2) p = __int_as_float(__float_as_int(p) & mask.bits(kb, r)); s[kb][r] = p; if (MODE != 2) ls += p; }
    st.l += ls;
    __builtin_amdgcn_sched_barrier(0);
    if (MODE == 2) pv_frags_sum(vf, s, st.o0, st.o1, st.o2, lane); else pv_frags(vf, s, st.o0, st.o1);
}
DI bf16x8 scale_frag(bf16x8 q, float c) {
    u32x4 u = __builtin_bit_cast(u32x4, q), o;
#pragma unroll
    for (int e = 0; e < 4; ++e) { const float lo = __uint_as_float(u[e] << 16) * c, hv = __uint_as_float(u[e] & 0xffff0000u) * c; o[e] = pk2(lo, hv); }
    return __builtin_bit_cast(bf16x8, o);
}
DI void attn_fold(const AttnState& st, float gate, f32x16& f0, f32x16& f1) {
    const float lt = sum_x32(st.l);
    const float sc = lt > 0.f ? gate / lt : 0.f;
#pragma unroll
    for (int r = 0; r < 16; ++r) { f0[r] += sc * st.o0[r]; f1[r] += sc * st.o1[r]; }
}
DI void attn_fold_lds(const AttnState& st, float gate, LAS float* fst) {
    const float lt = sum_x32(st.l);
    const float sc = lt > 0.f ? gate / lt : 0.f;
#pragma unroll
    for (int r4 = 0; r4 < 4; ++r4) { f32x4 a_ = *(const LAS f32x4*)(fst + 4 * r4), b_ = *(const LAS f32x4*)(fst + 16 + 4 * r4);
#pragma unroll
        for (int e = 0; e < 4; ++e) { a_[e] += sc * st.o0[4 * r4 + e]; b_[e] += sc * st.o1[4 * r4 + e]; }
        *(LAS f32x4*)(fst + 4 * r4) = a_; *(LAS f32x4*)(fst + 16 + 4 * r4) = b_; }
}
DI void store_rowT(bf16* dst, const f32x16& f0, const f32x16& f1, int hi) {
#pragma unroll
    for (int rr = 0; rr < 4; ++rr) {
        u32x2 w0; w0.x = pk2(f0[4 * rr], f0[4 * rr + 1]); w0.y = pk2(f0[4 * rr + 2], f0[4 * rr + 3]);
        u32x2 w1; w1.x = pk2(f1[4 * rr], f1[4 * rr + 1]); w1.y = pk2(f1[4 * rr + 2], f1[4 * rr + 3]);
        *(u32x2*)(dst + 8 * rr + 4 * hi) = w0; *(u32x2*)(dst + 32 + 8 * rr + 4 * hi) = w1;
    }
}
template <class RowPtr>
DI void store_rows_staged(LAS unsigned char* stage, const f32x16& f0, const f32x16& f1, int lane, RowPtr rowptr) {
    const int r32 = lane & 31, hi = lane >> 5;
#pragma unroll
    for (int rr = 0; rr < 4; ++rr) {
        u32x2 w0; w0.x = pk2(f0[4 * rr], f0[4 * rr + 1]); w0.y = pk2(f0[4 * rr + 2], f0[4 * rr + 3]);
        u32x2 w1; w1.x = pk2(f1[4 * rr], f1[4 * rr + 1]); w1.y = pk2(f1[4 * rr + 2], f1[4 * rr + 3]);
        *(LAS u32x2*)(stage + r32 * TP + (8 * rr + 4 * hi) * 2) = w0; *(LAS u32x2*)(stage + r32 * TP + (32 + 8 * rr + 4 * hi) * 2) = w1;
    }
    asm volatile("s_waitcnt lgkmcnt(0)" ::: "memory");
#pragma unroll
    for (int i = 0; i < 4; ++i) { const int ri = (lane >> 3) + 8 * i, ch = lane & 7; const u32x4 v = *(const LAS u32x4*)(stage + ri * TP + ch * 16); *(u32x4*)(rowptr(ri) + ch * 8) = v; }
    asm volatile("s_waitcnt lgkmcnt(0)" ::: "memory");
}

template <class M>
DI void attn_step_simple(LAS unsigned char* buf, int cur, int j, const bf16x8 (&qf)[4], AttnState& st, M& mask, int lane) {
    const int r32 = lane & 31, hi = lane >> 5;
    f32x16 sc[2];
    sc[0] = qk_block(buf + cur, 0, qf, st.negm, r32, hi); sc[1] = qk_block(buf + cur, 1, qf, st.negm, r32, hi);
    mask.begin(j);
    bf16x8 vf[8];
    v_frags(buf + cur + 9216, vf, lane);
    if (mask.full()) attn_softmax_pv<0>(sc, vf, st, mask, lane);
    else if (M::MODE == 1 && mask.rowonly()) attn_softmax_pv<3>(sc, vf, st, mask, lane);
    else attn_softmax_pv<M::MODE>(sc, vf, st, mask, lane);
}
template <bool BATCHV, class M>
DI void attn_step(LAS unsigned char* buf, int cur, int j, const bf16x8 (&qf)[4], AttnState& st, M& mask, int lane) {
    const int r32 = lane & 31, hi = lane >> 5;
    bf16x8 kf[2][4];
#pragma unroll
    for (int kb = 0; kb < 2; ++kb)
#pragma unroll
        for (int ks = 0; ks < 4; ++ks) kf[kb][ks] = *(const LAS bf16x8*)(buf + cur + (kb * 32 + r32) * TP + (ks * 16 + hi * 8) * 2);
    mask.begin(j);
    __builtin_amdgcn_sched_barrier(0);
    f32x16 sc[2];
#pragma unroll
    for (int kb = 0; kb < 2; ++kb)
#pragma unroll
        for (int ks = 0; ks < 4; ++ks) sc[kb] = (ks == 0) ? MFMA32(kf[kb][0], qf[0], st.negm) : MFMA32(kf[kb][ks], qf[ks], sc[kb]);
    bf16x8 vf[8];
    v_frags(buf + cur + 9216, vf, lane);
    if (BATCHV) __builtin_amdgcn_sched_barrier(0);
#if defined(X_VALU)
    {
        f32x16 e0 = sc[0], e1 = sc[1];
#pragma unroll
#if X_VALU == 2
        for (int r = 0; r < 16; ++r) { e0[r] = (e0[r] - 40.f) * e1[r] + 3.f; e1[r] = (e1[r] - 40.f) * e0[r] + 5.f; e0[r] = e0[r] * e1[r] + 1.f; e1[r] = e1[r] * 0.5f + e0[r]; }
#else
        for (int r = 0; r < 16; ++r) { e0[r] = __builtin_amdgcn_exp2f(e0[r] - 40.f); e1[r] = __builtin_amdgcn_exp2f(e1[r] - 40.f); }
#endif
        float acc = 0.f;
#pragma unroll
        for (int r = 0; r < 16; ++r) acc += e0[r] + e1[r];
        asm volatile("" :: "v"(acc));
    }
#endif
    if (mask.full()) attn_softmax_pv<0>(sc, vf, st, mask, lane);
    else if (M::MODE == 1 && mask.rowonly()) attn_softmax_pv<3>(sc, vf, st, mask, lane);
    else attn_softmax_pv<M::MODE>(sc, vf, st, mask, lane);
}
template <bool PRE, class M>
DI void attn_stream1(LAS unsigned char* buf, const bf16* kv0, int voff, size_t pitch, int j0, int j1, const bf16x8 (&qf)[4], AttnState& st, M& mask, int tid, int lane) {
    const int key = tid >> 3, ch = tid & 7;
    const bf16* gp = kv0 + (size_t)key * pitch + ch * 8;
    const int lo = key * TP + ch * 16;
    u32x4 rk, rv;
    if (!PRE) {
        rk = *(const u32x4*)(gp + (size_t)j0 * 64 * pitch); rv = *(const u32x4*)(gp + (size_t)j0 * 64 * pitch + voff);
        __syncthreads();
        *(LAS u32x4*)(buf + lo) = rk; *(LAS u32x4*)(buf + 9216 + lo) = rv;
        __syncthreads();
    }
    for (int j = j0; j <= j1; ++j) {
        const int cur = ((j - j0) & 1) * 18432;
        const int jp = j < j1 ? j + 1 : j1;
        rk = *(const u32x4*)(gp + (size_t)jp * 64 * pitch); rv = *(const u32x4*)(gp + (size_t)jp * 64 * pitch + voff);
        attn_step<false>(buf, cur, j, qf, st, mask, lane);
        *(LAS u32x4*)(buf + (cur ^ 18432) + lo) = rk; *(LAS u32x4*)(buf + (cur ^ 18432) + 9216 + lo) = rv;
        lds_barrier();
    }
}
template <class M, class Pre>
DI void attn_stream(LAS unsigned char* buf, const bf16* kv0, const bf16* nkv0, int voff, size_t pitch, int j0, int j1, const bf16x8 (&qf)[4], AttnState& st, M& mask, int tid, int lane,
                    u32x4& ka, u32x4& va, u32x4& kb_, u32x4& vb_, Pre pre  ) {
    const int key = tid >> 3, ch = tid & 7;
    const bf16* gp = kv0 + (size_t)key * pitch + ch * 8;
    const bf16* ngp = nkv0 + (size_t)key * pitch + ch * 8;
    const int lo = key * TP + ch * 16;
#define AS_LD(RK, RV, J) do { const bool in_ = (J) <= j1; const bf16* p_ = (in_ ? gp : ngp) + (size_t)(in_ ? (J) : (J) - j1 - 1) * 64 * pitch; RK = *(const u32x4*)(p_); RV = *(const u32x4*)(p_ + voff); } while (0)
#define AS_ST(SLOT, RK, RV) do { *(LAS u32x4*)(buf + (SLOT) + lo) = RK; *(LAS u32x4*)(buf + (SLOT) + 9216 + lo) = RV; } while (0)
    __syncthreads();
    pre();
    AS_ST(0, ka, va);
    __syncthreads();
    for (int j = j0; j <= j1; j += 2) {
        AS_LD(ka, va, j + 2);
        attn_step<true>(buf, 0, j, qf, st, mask, lane);
        AS_ST(18432, kb_, vb_);
        lds_barrier();
        if (j + 1 > j1) break;
        AS_LD(kb_, vb_, j + 3);
        attn_step<true>(buf, 18432, j + 1, qf, st, mask, lane);
        AS_ST(0, ka, va);
        lds_barrier();
    }
#undef AS_LD
#undef AS_ST
}
struct MaskSlc { static constexpr int MODE = 1; DI int bits(int, int) const { return -1; } unsigned sel; int t4, qb; bool rs, fl, ro; int lim;
    DI void begin(int j) { rs = (sel >> j) & 1u; lim = rs ? t4 - j * 64 : -1; ro = j < qb; fl = ro && __all(rs); }
    DI bool full() const { return fl; }
    DI bool rowonly() const { return ro; }
    DI bool rowsel() const { return rs; }
    DI bool operator()(int kb, int r) const { return (32 * kb + (r & 3) + 8 * (r >> 2)) <= lim; } };
struct MaskWin { static constexpr int MODE = 1; DI int bits(int, int) const { return -1; } int t4, qb; int lim; bool fl;
    DI void begin(int j) { lim = t4 - j * 64; fl = (j < qb) && (j >= qb - 7); }
    DI bool full() const { return fl; }
    DI bool rowonly() const { return false; }
    DI bool rowsel() const { return true; }
    DI bool operator()(int kb, int r) const { const int c = 32 * kb + (r & 3) + 8 * (r >> 2); return c <= lim && c > lim - 512; } };
struct MaskBits { static constexpr int MODE = 2; const LAS unsigned* row; int sh; unsigned w0, w1;
    DI void begin(int j) { w0 = row[2 * j] >> sh; w1 = row[2 * j + 1] >> sh; }
    DI bool full() const { return false; }
    DI bool rowonly() const { return false; }
    DI bool rowsel() const { return true; }
    DI bool operator()(int, int) const { return true; }
    DI int bits(int kb, int r) const { int m; asm("v_bfe_i32 %0, %1, %2, 1" : "=v"(m) : "v"(kb ? w1 : w0), "n"((r & 3) + 8 * (r >> 2))); return m; } };

DI void nsa_item(Frame& F, int it) {
    const int bg = it & 31, u = it >> 5, rq = u >> 3, sq = u & 7;
    const int qb = rq == 0 ? sq : rq == 1 ? 15 - sq : rq == 2 ? 16 + sq : 31 - sq;
    const int b = bg >> 1, g = bg & 1;
    const int tid = opaque(F.tid), lane = tid & 63, w = F.wave, r32 = lane & 31, hi = lane >> 5;
    LAS unsigned char* KT0 = F.lds; LAS unsigned char* VT0 = F.lds + 9216; LAS unsigned char* KT1 = F.lds + 18432; LAS unsigned char* VT1 = F.lds + 27648;
    LAS float* PS = (LAS float*)(F.lds + 36864) + w * 1024;
    LAS unsigned* SELM = (LAS unsigned*)(F.lds + 69632);
    LAS float* FST = (LAS float*)(F.lds + 70144) + w * 2304 + lane * 36;
    const bf16* P1 = (const bf16*)(F.ws + WS_BIG);
    const int t = qb * 64 + w * 8 + (r32 >> 2), hd = r32 & 3, head = g * 4 + hd;
    const bf16* rowp = P1 + (size_t)(b * SEQ + t) * BIGP;
    bf16x8 qf[4];
#pragma unroll
    for (int ks = 0; ks < 4; ++ks) qf[ks] = *(const bf16x8*)(rowp + C_Q + head * 64 + ks * 16 + hi * 8);
    const bf16 gr0 = rowp[C_GT + head * 3 + 0], gr1 = rowp[C_GT + head * 3 + 1], gr2 = rowp[C_GT + head * 3 + 2];
    const int ntc = (qb <= 15) ? 1 : 2, jw0 = (qb >= 8 ? qb - 8 : 0);
    const int lkey = tid >> 3, lch = tid & 7, llo = lkey * TP + lch * 16;
    u32x4 ck0, cv0, ck1, cv1, sk0, sv0, wk0, wv0;
    {
        const bf16* KC = (const bf16*)(F.ws + WS_KC) + (size_t)bg * 128 * 64 + (size_t)lkey * 64 + lch * 8; const bf16* VC = (const bf16*)(F.ws + WS_VC) + (size_t)bg * 128 * 64 + (size_t)lkey * 64 + lch * 8;
        ck0 = *(const u32x4*)KC; cv0 = *(const u32x4*)VC;
        ck1 = *(const u32x4*)(KC + (ntc == 2 ? 64 * 64 : 0)); cv1 = *(const u32x4*)(VC + (ntc == 2 ? 64 * 64 : 0));
        const bf16* sp = P1 + (size_t)(b * SEQ + lkey) * BIGP + C_KS + g * 64 + lch * 8;
        sk0 = *(const u32x4*)sp; sv0 = *(const u32x4*)(sp + (C_VS - C_KS));
        const bf16* wp = P1 + (size_t)(b * SEQ + jw0 * 64 + lkey) * BIGP + C_KW + g * 64 + lch * 8;
        wk0 = *(const u32x4*)wp; wv0 = *(const u32x4*)(wp + (C_VW - C_KW));
    }
    const float g0 = sigmoidf_(bf2f(gr0));
    FST[32] = sigmoidf_(bf2f(gr1)); FST[33] = sigmoidf_(bf2f(gr2));
#pragma unroll
    for (int ks = 0; ks < 4; ++ks) qf[ks] = scale_frag(qf[ks], 0.125f * 1.4426950408889634f);
    f32x16 f0, f1;
#pragma unroll
    for (int r = 0; r < 16; ++r) { f0[r] = 0.f; f1[r] = 0.f; }
    {
        __syncthreads();
        *(LAS u32x4*)(KT0 + llo) = ck0; *(LAS u32x4*)(VT0 + llo) = cv0;
        if (ntc == 2) { *(LAS u32x4*)(KT1 + llo) = ck1; *(LAS u32x4*)(VT1 + llo) = cv1; }
        __syncthreads();
        f32x16 sb[4];
        float mx = -INFINITY;
#pragma unroll
        for (int blk = 0; blk < 4; ++blk) {
            if ((blk >> 1) < ntc) {
                sb[blk] = qk_block((blk >> 1) ? KT1 : KT0, blk & 1, qf, f0, r32, hi);
#pragma unroll
                for (int r = 0; r < 16; ++r) { const int c = blk * 32 + crow(r, hi); if (16 * c + 31 <= t) mx = __builtin_amdgcn_fmed3f(mx, sb[blk][r], 3.4028234663852886e38f); }
            }
        }
        mx = max_x32(mx);
        const float mu = (mx == -INFINITY) ? 0.f : mx;
        float ls = 0.f;
#pragma unroll
        for (int blk = 0; blk < 4; ++blk) {
            if ((blk >> 1) < ntc) {
#pragma unroll
                for (int r = 0; r < 16; ++r) { const int c = blk * 32 + crow(r, hi); const float pe = (16 * c + 31 <= t) ? __builtin_amdgcn_exp2f(sb[blk][r] - mu) : 0.f; sb[blk][r] = pe; ls += pe; }
            }
        }
        ls = sum_x32(ls);
        const float inv = ls > 0.f ? __builtin_amdgcn_rcpf(ls) : 0.f;
        f32x16 o0, o1;
#pragma unroll
        for (int r = 0; r < 16; ++r) { o0[r] = 0.f; o1[r] = 0.f; }
#pragma unroll
        for (int blk = 0; blk < 4; ++blk) {
            f32x16 p;
            if ((blk >> 1) < ntc) {
#pragma unroll
                for (int r = 0; r < 16; ++r) p[r] = sb[blk][r] * inv;
                pv_block((blk >> 1) ? VT1 : VT0, blk & 1, p, o0, o1, lane);
            } else {
#pragma unroll
                for (int r = 0; r < 16; ++r) p[r] = 0.f;
            }
#pragma unroll
            for (int r4 = 0; r4 < 4; ++r4) { f32x4 v4;
#pragma unroll
                for (int e = 0; e < 4; ++e) { float v = p[4 * r4 + e]; v += dppf(v, DPP_XOR1); v += dppf(v, DPP_XOR2); v4[e] = v; }
                *(LAS f32x4*)(PS + (r32 >> 2) * 128 + blk * 32 + crow(4 * r4, hi)) = v4; }
        }
#pragma unroll
        for (int r4 = 0; r4 < 4; ++r4) { *(LAS f32x4*)(FST + 4 * r4) = (f32x4){o0[4 * r4] * g0, o0[4 * r4 + 1] * g0, o0[4 * r4 + 2] * g0, o0[4 * r4 + 3] * g0};
            *(LAS f32x4*)(FST + 16 + 4 * r4) = (f32x4){o1[4 * r4] * g0, o1[4 * r4 + 1] * g0, o1[4 * r4 + 2] * g0, o1[4 * r4 + 3] * g0}; }
        __syncthreads();
        {
            const int tok8 = lane >> 3, jq = lane & 7;
            float imp[4];
#pragma unroll
            for (int e = 0; e < 4; ++e) {
                const int j = 4 * jq + e; float v = 0.f;
#pragma unroll
                for (int dc = -1; dc <= 3; ++dc) { const int c = 4 * j + dc; if (c >= 0) v += PS[tok8 * 128 + c]; }
                if (j == 0 || j == qb || j == qb - 1) v = 1e4f;
                if (j > qb) v = -INFINITY;
                imp[e] = v;
            }
            unsigned sel = 0u;
            for (int itr = 0; itr < 8; ++itr) {
                float bv = imp[0]; int bj = 4 * jq;
#pragma unroll
                for (int e = 1; e < 4; ++e) if (imp[e] > bv) { bv = imp[e]; bj = 4 * jq + e; }
#pragma unroll
#define TOP_STEP(CTL) do { const float ov = dppf(bv, CTL); const int oj = __builtin_amdgcn_update_dpp(0, bj, CTL, 0xf, 0xf, true); if (ov > bv || (ov == bv && oj < bj)) { bv = ov; bj = oj; } } while (0)
                TOP_STEP(DPP_XOR1); TOP_STEP(DPP_XOR2); TOP_STEP(DPP_HMIR);
#undef TOP_STEP
                sel |= 1u << bj;
#pragma unroll
                for (int e = 0; e < 4; ++e) if (4 * jq + e == bj) imp[e] = -INFINITY;
            }
            if (jq == 0) SELM[w * 8 + tok8] = sel;
        }
        __syncthreads();
    }
    const unsigned mysel = SELM[w * 8 + (r32 >> 2)];
    LAS unsigned char* PSW = F.lds + 36864;
    *(LAS u32x4*)(F.lds + llo) = sk0; *(LAS u32x4*)(F.lds + 9216 + llo) = sv0;
    *(LAS u32x4*)(PSW + llo) = wk0; *(LAS u32x4*)(PSW + 9216 + llo) = wv0;
    __syncthreads();
    {
        AttnState st; attn_init(st);
        MaskSlc mk; mk.sel = mysel; mk.t4 = t - 4 * hi; mk.qb = qb;
        attn_stream1<true>(F.lds, P1 + (size_t)(b * SEQ) * BIGP + C_KS + g * 64, C_VS - C_KS, BIGP, 0, qb, qf, st, mk, tid, lane);
        attn_fold_lds(st, FST[32], FST);
    }
    {
        {
            const u32x4 tk = *(const LAS u32x4*)(PSW + llo), tv = *(const LAS u32x4*)(PSW + 9216 + llo);
            *(LAS u32x4*)(F.lds + llo) = tk; *(LAS u32x4*)(F.lds + 9216 + llo) = tv;
            lds_barrier();
        }
        AttnState st; attn_init(st);
        MaskWin mk; mk.t4 = t - 4 * hi; mk.qb = qb;
        attn_stream1<true>(F.lds, P1 + (size_t)(b * SEQ) * BIGP + C_KW + g * 64, C_VW - C_KW, BIGP, jw0, qb, qf, st, mk, tid, lane);
        const float lt = sum_x32(st.l), scw = lt > 0.f ? FST[33] / lt : 0.f;
#pragma unroll
        for (int r4 = 0; r4 < 4; ++r4) { const f32x4 a_ = *(const LAS f32x4*)(FST + 4 * r4), b_ = *(const LAS f32x4*)(FST + 16 + 4 * r4);
#pragma unroll
            for (int e = 0; e < 4; ++e) { f0[4 * r4 + e] = a_[e] + scw * st.o0[4 * r4 + e]; f1[4 * r4 + e] = b_[e] + scw * st.o1[4 * r4 + e]; } }
    }
    bf16* Y = (bf16*)(F.ws + WS_Y);
    {
        bf16* ybase = Y + (size_t)(b * SEQ + qb * 64 + w * 8) * DM + 512 + g * 256;
        store_rows_staged(F.lds + w * 4608, f0, f1, lane, [&](int ri) { return ybase + (size_t)(ri >> 2) * DM + (ri & 3) * 64; });
    }
}

DI unsigned f2key(float f) { unsigned u = __float_as_uint(f); if (u == 0x80000000u) u = 0u; return (u & 0x80000000u) ? ~u : (u | 0x80000000u); }
DI float key2f(unsigned k) { return __uint_as_float((k & 0x80000000u) ? (k & 0x7fffffffu) : ~k); }
DI int row_sum16(int v) {
    v += __builtin_amdgcn_update_dpp(0, v, 0xB1, 0xf, 0xf, true);
    v += __builtin_amdgcn_update_dpp(0, v, 0x4E, 0xf, 0xf, true);
    v += __builtin_amdgcn_update_dpp(0, v, 0x141, 0xf, 0xf, true);
    v += __builtin_amdgcn_update_dpp(0, v, 0x140, 0xf, 0xf, true);
    return v;
}
#define dppu(v, ctrl) ((unsigned)__builtin_amdgcn_update_dpp(0, (int)(v), (ctrl), 0xf, 0xf, true))
DI unsigned bt_stage(unsigned x, unsigned p, bool upper, int j, unsigned m) {
    const unsigned a = upper ? x : p, b = upper ? p : x;
    const unsigned t = ((a >> j) ^ b) & m;
    return upper ? (x ^ (t << j)) : (x ^ t);
}
DI unsigned transpose32(unsigned x, int l) {
    { auto rr = __builtin_amdgcn_permlane16_swap(x, x, false, false); const unsigned p = ((l >> 4) & 1) ? rr[0] : rr[1]; x = bt_stage(x, p, !(l & 16), 16, 0x0000FFFFu); }
    { const unsigned p = dppu(x, 0x128);                 x = bt_stage(x, p, !(l & 8), 8, 0x00FF00FFu); }
    { const unsigned p = dppu(dppu(x, 0x141), 0x1B);     x = bt_stage(x, p, !(l & 4), 4, 0x0F0F0F0Fu); }
    { const unsigned p = dppu(x, 0x4E);                  x = bt_stage(x, p, !(l & 2), 2, 0x33333333u); }
    { const unsigned p = dppu(x, 0xB1);                  x = bt_stage(x, p, !(l & 1), 1, 0x55555555u); }
    return x;
}
struct IdxPre { bf16x8 af[2]; bf16 w4r[4]; u32x4 rr[4]; };
DI void dsa_index_decode(int it, int& b, int& qt16) { const int u_ = it >> 4, k_ = u_ >> 4, s_ = u_ & 15; b = it & 15; qt16 = (k_ & 1) ? 32 * (k_ >> 1) + 31 - s_ : 32 * (k_ >> 1) + s_; }
DI void dsa_index_front(Frame& F, int it, IdxPre& P) {
    int b, qt16; dsa_index_decode(it, b, qt16);
    const int tid = opaque(F.tid), lane = tid & 63, w = F.wave, hi = lane >> 5, key16 = lane & 15, g4 = lane >> 4;
    const bf16* L1 = (const bf16*)(F.ws + WS_BIG);
    {
        const int row = key16, q = row >> 3, h = row & 7;
        const bf16* qp = L1 + (size_t)(b * SEQ + qt16 * 16 + w * 2 + q) * BIGP + D_QI + h * 64 + g4 * 8;
        P.af[0] = *(const bf16x8*)(qp); P.af[1] = *(const bf16x8*)(qp + 32);
    }
#pragma unroll
    for (int i = 0; i < 4; ++i) P.w4r[i] = L1[(size_t)(b * SEQ + qt16 * 16 + w * 2 + hi) * BIGP + D_WI + 4 * (g4 & 1) + i];
    const bf16* gp = L1 + (size_t)(b * SEQ + (tid >> 3)) * BIGP + D_KI + (tid & 7) * 8;
#pragma unroll
    for (int i = 0; i < 4; ++i) P.rr[i] = *(const u32x4*)(gp + (size_t)(64 * i) * BIGP);
}
DI void dsa_index_item(Frame& F, int it, int itn, IdxPre& P) {
    int b, qt16; dsa_index_decode(it, b, qt16);
    const int tid = opaque(F.tid), lane = tid & 63, w = F.wave, r32 = lane & 31, hi = lane >> 5, key16 = lane & 15, g4 = lane >> 4;
    const bf16* L1 = (const bf16*)(F.ws + WS_BIG);
    LAS unsigned char* ring = F.lds;
    const int tq = qt16 * 16 + w * 2 + hi;
    typedef float f32x4_t __attribute__((ext_vector_type(4)));
    bf16x8 af[2];
    af[0] = P.af[0]; af[1] = P.af[1];
    float w4[4];
#pragma unroll
    for (int i = 0; i < 4; ++i) w4[i] = bf2f(P.w4r[i]) * (0.125f * 0.35355339059327373f);
    const int nslab = (((qt16 * 16 + 15) >> 6) >> 2) + 1;
    float sf[64];
#pragma unroll
    for (int kb = 0; kb < 64; ++kb) sf[kb] = -INFINITY;
    {
        const int key = tid >> 3, ch = tid & 7;
        const bf16* gp = L1 + (size_t)(b * SEQ + key) * BIGP + D_KI + ch * 8;
        const int lo = key * TP + ch * 16;
        u32x4 rr[4];
#pragma unroll
        for (int i = 0; i < 4; ++i) rr[i] = P.rr[i];
#define IX_LD(S) do { _Pragma("unroll") for (int i_ = 0; i_ < 4; ++i_) rr[i_] = *(const u32x4*)(gp + (size_t)((S) * 256 + 64 * i_) * BIGP); } while (0)
#define IX_ST(SLOT) do { _Pragma("unroll") for (int i_ = 0; i_ < 4; ++i_) *(LAS u32x4*)(ring + (SLOT) + i_ * 64 * TP + lo) = rr[i_]; } while (0)
        __syncthreads();
        IX_ST(0);
        __syncthreads();
#pragma unroll
        for (int sl = 0; sl < 8; ++sl) {
            if (sl < nslab) {
                const int cur = (sl & 1) * 36864;
                if (sl + 1 < nslab) IX_LD(sl + 1);
#pragma unroll
                for (int kl = 0; kl < 8; ++kl) {
                    f32x4_t a0 = {0.f, 0.f, 0.f, 0.f}, a1 = {0.f, 0.f, 0.f, 0.f};
#pragma unroll
                    for (int ks2 = 0; ks2 < 2; ++ks2) {
                        const bf16x8 b0 = *(const LAS bf16x8*)(ring + cur + (kl * 32 + key16) * TP + (32 * ks2 + 8 * g4) * 2);
                        const bf16x8 b1 = *(const LAS bf16x8*)(ring + cur + (kl * 32 + 16 + key16) * TP + (32 * ks2 + 8 * g4) * 2);
                        a0 = __builtin_amdgcn_mfma_f32_16x16x32_bf16(af[ks2], b0, a0, 0, 0, 0);
                        a1 = __builtin_amdgcn_mfma_f32_16x16x32_bf16(af[ks2], b1, a1, 0, 0, 0);
                    }
                    float s0 = 0.f, s1 = 0.f;
#pragma unroll
                    for (int i = 0; i < 4; ++i) { s0 += w4[i] * __builtin_amdgcn_fmed3f(a0[i], 0.f, 3.4028234663852886e38f); s1 += w4[i] * __builtin_amdgcn_fmed3f(a1[i], 0.f, 3.4028234663852886e38f); }
                    const bool odd = g4 & 1;
                    const float keep = odd ? s1 : s0, give = odd ? s0 : s1;
                    float full = keep + xor16f(give, odd);
                    if (full == 0.f) full = 0.f;
                    const int kidx = (sl * 8 + kl) * 32 + r32;
                    sf[sl * 8 + kl] = kidx <= tq ? full : -INFINITY;
                }
                if (sl + 1 < nslab) IX_ST(cur ^ 36864);
                lds_barrier();
            }
        }
#undef IX_LD
#undef IX_ST
    }
    dsa_index_front(F, itn, P);
    const int tqb = __builtin_amdgcn_readfirstlane(qt16 * 16 + w * 2);
    const bool fullq0 = tqb < 256, fullq1 = tqb + 1 < 256;
    unsigned tau0 = 0u, tau1 = 0u; bool ex0 = fullq0, ex1 = fullq1;
    const int ngrp = (((tqb + 1) >> 5) + 8) >> 3;
#define IDX_GRP(W, G) if ((G) < ngrp) { _Pragma("unroll") for (int kb = 8 * (G); kb < 8 * (G) + 8; ++kb) W = __builtin_amdgcn_alignbit(W, __float_as_uint(sf[kb] - cf_), 31); }
#define IDX_COUNT_LT(C0, C1, N0, N1) do { const float cf_ = hi ? key2f(C1) : key2f(C0); unsigned wl_ = 0u, wh_ = 0u; \
        IDX_GRP(wl_, 0) IDX_GRP(wl_, 1) IDX_GRP(wl_, 2) IDX_GRP(wl_, 3) IDX_GRP(wh_, 4) IDX_GRP(wh_, 5) IDX_GRP(wh_, 6) IDX_GRP(wh_, 7) \
        const int rs_ = row_sum16(__popc(wl_) + __popc(wh_)); const int skip_ = (8 - ngrp) * 256;     \
        N0 = __builtin_amdgcn_readlane(rs_, 0) + __builtin_amdgcn_readlane(rs_, 16) + skip_; N1 = __builtin_amdgcn_readlane(rs_, 32) + __builtin_amdgcn_readlane(rs_, 48) + skip_; } while (0)
    unsigned lo0 = 0u, lo1 = 0u, hi0, hi1, gs0 = 0u, gs1 = 0u;
    {
        float mxl = -INFINITY;
#pragma unroll
        for (int kb = 0; kb < 64; ++kb) if ((kb >> 3) < ngrp) mxl = __builtin_amdgcn_fmed3f(mxl, sf[kb], 3.4028234663852886e38f);
        mxl = fmaxf(mxl, dppf(mxl, DPP_XOR1)); mxl = fmaxf(mxl, dppf(mxl, DPP_XOR2)); mxl = fmaxf(mxl, dppf(mxl, DPP_HMIR)); mxl = fmaxf(mxl, dppf(mxl, DPP_MIR));
        const unsigned m0 = f2key(fmaxf(__uint_as_float(__builtin_amdgcn_readlane(__float_as_uint(mxl), 0)), __uint_as_float(__builtin_amdgcn_readlane(__float_as_uint(mxl), 16))));
        const unsigned m1 = f2key(fmaxf(__uint_as_float(__builtin_amdgcn_readlane(__float_as_uint(mxl), 32)), __uint_as_float(__builtin_amdgcn_readlane(__float_as_uint(mxl), 48))));
        hi0 = m0 + 1u; hi1 = m1 + 1u;
        if (m0 > 0x83000000u) gs0 = m0 - (5u << 23);
        if (m1 > 0x83000000u) gs1 = m1 - (5u << 23);
    }
    bool dn0 = fullq0, dn1 = fullq1;
    for (int itn = 0; itn < 40; ++itn) {
        const unsigned c0 = dn0 ? lo0 : (gs0 ? gs0 : lo0 + ((hi0 - lo0) >> 1)), c1 = dn1 ? lo1 : (gs1 ? gs1 : lo1 + ((hi1 - lo1) >> 1));
        gs0 = 0u; gs1 = 0u;
        int l0, l1; IDX_COUNT_LT(c0, c1, l0, l1);
        const int g0 = 2048 - l0, g1 = 2048 - l1;
        if (!dn0) { if (g0 >= 256) { lo0 = c0; if (g0 == 256) { ex0 = true; dn0 = true; } } else hi0 = c0; if (hi0 - lo0 <= 1u) dn0 = true; }
        if (!dn1) { if (g1 >= 256) { lo1 = c1; if (g1 == 256) { ex1 = true; dn1 = true; } } else hi1 = c1; if (hi1 - lo1 <= 1u) dn1 = true; }
        if (dn0 && dn1) break;
    }
    tau0 = lo0; tau1 = lo1;
    const bool anytie = !(ex0 && ex1);
    int need = 0;
    if (anytie) { int l0, l1; IDX_COUNT_LT(tau0 + 1u, tau1 + 1u, l0, l1); need = 256 - (2048 - (hi ? l1 : l0)); }
#undef IDX_COUNT_LT
#undef IDX_GRP
    const float ft = hi ? key2f(tau1) : key2f(tau0);
    const bool exact = hi ? ex1 : ex0, full_q = hi ? fullq1 : fullq0;
    int running = 0; unsigned w0 = 0u, w1 = 0u;
    if (!anytie) {
        const float fte = full_q ? -3.4028234663852886e38f : ft;
        unsigned nlo = 0u, nhi = 0u;
#pragma unroll
        for (int kb = 31; kb >= 0; --kb) nlo = __builtin_amdgcn_alignbit(nlo, __float_as_uint(sf[kb] - fte), 31);
#pragma unroll
        for (int kb = 63; kb >= 32; --kb) nhi = __builtin_amdgcn_alignbit(nhi, __float_as_uint(sf[kb] - fte), 31);
        w0 = transpose32(~nlo, r32); w1 = transpose32(~nhi, r32);
    } else
#pragma unroll
    for (int kb = 0; kb < 64; ++kb) {
        if ((kb >> 3) >= ngrp) continue;
        bool sel = sf[kb] >= ft;
        if (anytie) {
            const bool tie = (sf[kb] == ft);
            const unsigned long long bal = __ballot(tie);
            const unsigned hb = hi ? (unsigned)(bal >> 32) : (unsigned)bal;
            const int before = running + __popc(hb & ((1u << r32) - 1u));
            running += __popc(hb);
            if (!exact) sel = (sf[kb] > ft) || (tie && before < need);
        }
        if (full_q) sel = (kb * 32 + r32) <= tq;
        const unsigned long long sb = __ballot(sel);
        const unsigned word = hi ? (unsigned)(sb >> 32) : (unsigned)sb;
        if (r32 == (kb & 31)) { if (kb < 32) w0 = word; else w1 = word; }
    }
    unsigned* MASK = (unsigned*)(F.ws + WS_MASK) + ((size_t)(b * 64 + (qt16 >> 1)) * 32 + (qt16 & 1) * 16 + w * 2 + hi) * 64;
    MASK[r32] = w0; MASK[32 + r32] = w1;
}

struct DsaPre { bf16x8 qf[4]; unsigned mwd[4]; u32x4 ka, va, kb, vb; int odd; };
DI void dsa_attn_decode(int it, int& b, int& g, int& qt) { const int bg = it & 31, u = it >> 5, rq = u >> 3, sq = u & 7; qt = (rq >> 1) * 16 + ((rq & 1) ? 15 - sq : sq); b = bg >> 1; g = bg & 1; }
DI void dsa_attn_front(Frame& F, int it, DsaPre& P) {
    int b, g, qt; dsa_attn_decode(it, b, g, qt);
    const int tid = opaque(F.tid), lane = tid & 63, w = F.wave, r32 = lane & 31, hi = lane >> 5;
    const bf16* L1 = (const bf16*)(F.ws + WS_BIG);
    const unsigned* MASK = (const unsigned*)(F.ws + WS_MASK) + (size_t)(b * 64 + qt) * 32 * 64;
    const bf16* rowp = L1 + (size_t)(b * SEQ + qt * 32 + r32) * BIGP;
#pragma unroll
    for (int ks = 0; ks < 4; ++ks) P.qf[ks] = *(const bf16x8*)(rowp + D_Q + (g * 8 + w) * 64 + ks * 16 + hi * 8);
#pragma unroll
    for (int e = 0; e < 4; ++e) P.mwd[e] = MASK[tid + e * NTHR];
}
DI void dsa_attn_front_kv(Frame& F, int it, DsaPre& P) {
    int b, g, qt; dsa_attn_decode(it, b, g, qt);
    const int tid = opaque(F.tid), key = tid >> 3, ch = tid & 7;
    const bf16* gp = (const bf16*)(F.ws + WS_BIG) + (size_t)(b * SEQ + key) * BIGP + D_K + g * 64 + ch * 8;
    const int t1 = (qt >> 1) >= 1 ? 1 : 0;
    P.ka = *(const u32x4*)gp; P.va = *(const u32x4*)(gp + (D_V - D_K)); P.kb = *(const u32x4*)(gp + (size_t)t1 * 64 * BIGP); P.vb = *(const u32x4*)(gp + (size_t)t1 * 64 * BIGP + (D_V - D_K)); P.odd = 0;
}
DI void dsa_attn_item(Frame& F, int it, int itn, DsaPre& P) {
    int b, g, qt; dsa_attn_decode(it, b, g, qt);
    int nb, ng, nqt; dsa_attn_decode(itn, nb, ng, nqt);
    const int tid = opaque(F.tid), lane = tid & 63, w = F.wave, r32 = lane & 31, hi = lane >> 5;
    const bf16* L1 = (const bf16*)(F.ws + WS_BIG);
    LAS unsigned* MASKL = (LAS unsigned*)(F.lds + 55296);
    const int head = g * 8 + w;
    bf16x8 qf[4];
#pragma unroll
    for (int ks = 0; ks < 4; ++ks) qf[ks] = P.qf[ks];
    unsigned mwd[4];
#pragma unroll
    for (int e = 0; e < 4; ++e) mwd[e] = P.mwd[e];
    if (P.odd) { const u32x4 tk = P.ka, tv = P.va; P.ka = P.kb; P.va = P.vb; P.kb = tk; P.vb = tv; }
    AttnState st; attn_init(st);
    MaskBits mk; mk.row = MASKL + r32 * 65; mk.sh = 4 * hi;
    attn_stream(F.lds, L1 + (size_t)(b * SEQ) * BIGP + D_K + g * 64, L1 + (size_t)(nb * SEQ) * BIGP + D_K + ng * 64, D_V - D_K, BIGP, 0, qt >> 1, qf, st, mk, tid, lane, P.ka, P.va, P.kb, P.vb, [&]() {
#pragma unroll
        for (int e = 0; e < 4; ++e) { const int idx = tid + e * NTHR; MASKL[(idx >> 6) * 65 + (idx & 63)] = mwd[e]; }
#pragma unroll
        for (int ks = 0; ks < 4; ++ks) qf[ks] = scale_frag(qf[ks], 0.125f * 1.4426950408889634f); });
    P.odd = ((qt >> 1) + 1) & 1;
    if ((qt >> 1) == 0) {
        const bf16* ngp = L1 + (size_t)(nb * SEQ + (tid >> 3)) * BIGP + D_K + ng * 64 + (tid & 7) * 8;
        P.kb = *(const u32x4*)ngp; P.vb = *(const u32x4*)(ngp + (D_V - D_K)); }
    dsa_attn_front(F, itn, P);
    f32x16 f0, f1;
#pragma unroll
    for (int r = 0; r < 16; ++r) { f0[r] = 0.f; f1[r] = 0.f; }
    { const float lt = sum_x32(st.o2[0]), sc = lt > 0.f ? __builtin_amdgcn_rcpf(lt) : 0.f;
#pragma unroll
      for (int r = 0; r < 16; ++r) { f0[r] = sc * st.o0[r]; f1[r] = sc * st.o1[r]; } }
    bf16* Y = (bf16*)(F.ws + WS_Y);
    {
        bf16* ybase = Y + (size_t)(b * SEQ + qt * 32) * DM + head * 64;
        store_rows_staged(F.lds + w * 4608, f0, f1, lane, [&](int ri) { return ybase + (size_t)ri * DM; });
    }
}

#ifndef REP_P0
#define REP_P0 1
#endif
#ifndef REP_NORM
#define REP_NORM 1
#endif
#ifndef REP_GIN0
#define REP_GIN0 1
#endif
#ifndef REP_LRU1
#define REP_LRU1 1
#endif
#ifndef REP_NSA
#define REP_NSA 1
#endif
#ifndef REP_GGU
#define REP_GGU 1
#endif
#ifndef REP_DIDX
#define REP_DIDX 1
#endif
#ifndef REP_DATT
#define REP_DATT 1
#endif
__global__ void __launch_bounds__(NTHR) fwd_megakernel(Args args) {
    extern __shared__ __attribute__((aligned(16))) unsigned char lds_raw[];
    Frame F;
    F.lds = (LAS unsigned char*)lds_raw;
    F.tid = threadIdx.x; F.lane = F.tid & 63; F.wave = __builtin_amdgcn_readfirstlane(F.tid >> 6);
    F.G = gridDim.x; F.bid = blockIdx.x;
    F.in = args.in; F.out = args.out; F.ws = args.ws;
    unsigned char* ws = args.ws;
    const float* MOD0 = (const float*)(ws + WS_MOD0); const float* MOD1 = (const float*)(ws + WS_MOD1);
    bf16* X16 = (bf16*)(ws + WS_X16);
    bf16* XN = (bf16*)(ws + WS_XN); bf16* BIG = (bf16*)(ws + WS_BIG); bf16* Y = (bf16*)(ws + WS_Y);
    typedef pg8::StaticOrder SO;
#ifdef REP_K
    typedef pg8::DoubleOrder SOK;
#else
    typedef pg8::StaticOrder SOK;
#endif
    volatile LAS unsigned* MISC = (volatile LAS unsigned*)(F.lds + 131072 + 18432 + 512);
    if (F.tid < 32) MISC[F.tid] = 0u;
    __syncthreads();
    const XcdBarrier bar = xcd_barrier_post((unsigned*)ws, MISC + 8);
#define GRID_SYNC() xcd_barrier(bar)
    if (F.tid == 0) ((unsigned*)ws)[GB_XID(F.bid)] = bar.x + 1u;
#define NROW0 (256 * (16 * (F.bid & 7) + 4 * (F.bid >> 6) + ((F.bid >> 3) & 3)) + 128 * ((F.bid >> 5) & 1))
#define OFF_ (F.bid >> 3)
#define B2_ (2 * (F.bid & 7) + (OFF_ & 1))
#define VB_LRU ((B2_ << 4) | (OFF_ >> 1))
#define VB_CMP (((OFF_ >> 4) << 7) | (B2_ << 3) | ((OFF_ >> 1) & 7))
#define VB_ATT ((B2_ << 1) | ((OFF_ >> 1) & 1) | ((OFF_ >> 2) << 5))
#define VB_IDX (B2_ | ((OFF_ >> 1) << 4))
#define GRP_SYNC(e) grp_barrier(GrpBarrier{(unsigned*)ws, (unsigned)GB_CNT((F.bid & 7) * 4 + ((F.bid >> 3) & 3)), 8u, MISC + 12}, (e))
#define XCD_SYNC(e) grp_barrier(GrpBarrier{(unsigned*)ws, (unsigned)XG_CNT(F.bid & 7), 32u, MISC + 13}, (e))

#ifndef PHMASK
#define PHMASK 0xffffffu
#endif
#define PH(n) F.lane = fresh_lane(); F.tid = F.wave * 64 + F.lane; if (PHMASK & (1u << (n)))
    for (int rep_ = 0; rep_ < REP_P0; ++rep_) {
    PH(0) p0_prologue(F);
    GRID_SYNC();
    }
    if (F.tid == 0) {
        bool same8 = true, same32 = true;
        for (int k = 0; k < 32; ++k) { const bool s = xb_ld(&((unsigned*)ws)[GB_XID((F.bid & 7) + 8 * k)]) == bar.x + 1u; same32 = same32 && s; if ((k & 3) == ((F.bid >> 3) & 3)) same8 = same8 && s; }
        MISC[12] = same8 ? 2u : 1u; MISC[13] = same32 ? 2u : 1u;
#ifdef FORCE_SLOW_GB
        MISC[12] = 1u; MISC[13] = 1u;
#endif
    }
    for (int rep_ = 0; rep_ < REP_NORM; ++rep_) {
    PH(1) norm_mod_phase(F, F.in[0], F.in[2], MOD0 + 0, MOD0 + 1024, XN, NROW0, 128);
    GRP_SYNC(1 + rep_);
    }
    for (int rep_ = 0; rep_ < REP_GIN0; ++rep_) {
    PH(2) { pg8::Gemm g{XN, (const bf16*)(ws + WS_WIN0), MROWS, IN0P, DM}; SO S; S.init(MROWS, IN0P, F.G, F.bid); pg8::EpiStoreBf16 E{BIG, BIGP};
      pg8::gemm_phase<pg8::EpiStoreBf16, SO, true, true>(F.lds, g, S, E, F.wave); }
    }
    XCD_SYNC(1);
    for (int rep_ = 0; rep_ < REP_LRU1; ++rep_) {
    { PH(3) lru_fused_item(F, VB_LRU); } { PH(4) cmp_item(F, VB_CMP); }
    }
    XCD_SYNC(2);
    for (int rep_ = 0; rep_ < REP_NSA; ++rep_) {
    _Pragma("unroll 1") for (int k = 0; k < 4; ++k) { PH(5) nsa_item(F, VB_ATT + 256 * k); }
    }
    XCD_SYNC(3);
    PH(7) { pg8::Gemm g{Y, (const bf16*)(ws + WS_WOUT0), MROWS, DM, DM}; SO S; S.init(MROWS, DM, F.G, F.bid); pg8::EpiResGate16<true> E{F.in[0], X16, MOD0 + 2048, 6144};
      pg8::gemm_phase<pg8::EpiResGate16<true>, SO, true, true>(F.lds, g, S, E, F.wave); }
    GRP_SYNC(REP_NORM + 1);
    PH(8) norm_mod_phase16(F, X16, F.in[3], MOD0 + 3072, MOD0 + 4096, XN, NROW0, 128);
    GRP_SYNC(REP_NORM + 2);
    for (int rep_ = 0; rep_ < REP_GGU; ++rep_) {
    PH(9) { pg8::Gemm g{XN, (const bf16*)(ws + WS_WGU0), MROWS, 2 * DFF, DM}; SOK S; S.init(MROWS, 2 * DFF, F.G, F.bid); pg8::EpiSwiGLU E{BIG, DFF};
      pg8::gemm_phase<pg8::EpiSwiGLU, SOK, true, true>(F.lds, g, S, E, F.wave); }
    }
    GRP_SYNC(REP_NORM + 3);
    PH(10) { pg8::Gemm g{BIG, (const bf16*)(ws + WS_WD0), MROWS, DM, DFF}; SO S; S.init(MROWS, DM, F.G, F.bid); pg8::EpiResGate16<false> E{X16, X16, MOD0 + 5120, 6144};
      pg8::gemm_phase<pg8::EpiResGate16<false>, SO, true, true>(F.lds, g, S, E, F.wave); }
    GRP_SYNC(REP_NORM + 4);
    PH(11) norm_mod_phase16(F, X16, F.in[24], MOD1 + 0, MOD1 + 1024, XN, NROW0, 128);
    GRP_SYNC(REP_NORM + 5);
    PH(12) { pg8::Gemm g{XN, (const bf16*)(ws + WS_WIN1), MROWS, IN1P, DM}; SO S; S.init(MROWS, IN1P, F.G, F.bid); pg8::EpiStoreBf16 E{BIG, BIGP};
      pg8::gemm_phase<pg8::EpiStoreBf16, SO, true, true>(F.lds, g, S, E, F.wave); }
    XCD_SYNC(4);
    for (int rep_ = 0; rep_ < REP_DIDX; ++rep_) {
    PH(13) { IdxPre P_; dsa_index_front(F, VB_IDX, P_);
      _Pragma("unroll 1") for (int k = 0; k < 8; ++k) dsa_index_item(F, VB_IDX + 256 * k, VB_IDX + 256 * (k < 7 ? k + 1 : k), P_); }
    }
    XCD_SYNC(5);
    for (int rep_ = 0; rep_ < REP_DATT; ++rep_) {
    PH(14) { DsaPre P_; dsa_attn_front(F, VB_ATT, P_); dsa_attn_front_kv(F, VB_ATT, P_);
      _Pragma("unroll 1") for (int k = 0; k < 8; ++k) dsa_attn_item(F, VB_ATT + 256 * k, VB_ATT + 256 * (k < 7 ? k + 1 : k), P_); }
    }
    XCD_SYNC(6);
    PH(15) { pg8::Gemm g{Y, (const bf16*)(ws + WS_WOUT1), MROWS, DM, DM}; SO S; S.init(MROWS, DM, F.G, F.bid); pg8::EpiResGate16<false> E{X16, X16, MOD1 + 2048, 6144};
      pg8::gemm_phase<pg8::EpiResGate16<false>, SO, true, true>(F.lds, g, S, E, F.wave); }
    GRP_SYNC(REP_NORM + 6);
    PH(16) norm_mod_phase16(F, X16, F.in[25], MOD1 + 3072, MOD1 + 4096, XN, NROW0, 128);
    GRP_SYNC(REP_NORM + 7);
    PH(17) { pg8::Gemm g{XN, (const bf16*)(ws + WS_WGU1), MROWS, 2 * DFF, DM}; SOK S; S.init(MROWS, 2 * DFF, F.G, F.bid); pg8::EpiSwiGLU E{BIG, DFF};
      pg8::gemm_phase<pg8::EpiSwiGLU, SOK, true, true>(F.lds, g, S, E, F.wave); }
    GRP_SYNC(REP_NORM + 8);
    PH(18) { pg8::Gemm g{BIG, (const bf16*)(ws + WS_WD1), MROWS, DM, DFF}; SO S; S.init(MROWS, DM, F.G, F.bid); pg8::EpiResGate16<false> E{X16, X16, MOD1 + 5120, 6144};
      pg8::gemm_phase<pg8::EpiResGate16<false>, SO, true, true>(F.lds, g, S, E, F.wave); }
    GRP_SYNC(REP_NORM + 9);
    PH(19) final_norm_phase16(F, X16, F.out, F.in[33], NROW0, 128);
}

extern "C" void kernel_launch(void* const* d_in, const int* in_sizes, int n_in, void* d_out, int out_size, void* d_ws, size_t ws_size, hipStream_t stream) {
    static int grid = 0;
    if (grid == 0) {
        if (n_in != 34 || in_sizes[0] != MROWS * DM || out_size != MROWS * DM || ws_size < WS_END) {
            fprintf(stderr, "kernel_launch: unexpected shapes (n_in %d, in0 %d, out %d, ws %zu); nothing launched\n", n_in, n_in > 0 ? in_sizes[0] : -1, out_size, ws_size); grid = -1; return; }
        int dev = 0, cus = 0, per_cu = 0;
        if (hipGetDevice(&dev) != hipSuccess || hipDeviceGetAttribute(&cus, hipDeviceAttributeMultiprocessorCount, dev) != hipSuccess) { grid = -1; return; }
        if (hipFuncSetAttribute((const void*)fwd_megakernel, hipFuncAttributeMaxDynamicSharedMemorySize, LDS_BYTES) != hipSuccess) { fprintf(stderr, "kernel_launch: hipFuncSetAttribute failed\n"); grid = -1; return; }
        if (hipOccupancyMaxActiveBlocksPerMultiprocessor(&per_cu, (const void*)fwd_megakernel, NTHR, LDS_BYTES) != hipSuccess || per_cu < 1) { fprintf(stderr, "kernel_launch: occupancy query says %d\n", per_cu); grid = -1; return; }
        if (cus != 256) { fprintf(stderr, "kernel_launch: the row-group work split needs 256 CUs (MI355X), found %d; nothing launched\n", cus); grid = -1; return; }
        grid = cus;
    }
    if (grid < 0) return;
    Args a{};
    for (int i = 0; i < 34; ++i) a.in[i] = (const float*)d_in[i];
    a.out = (float*)d_out; a.ws = (unsigned char*)d_ws;
    if (hipMemsetAsync(d_ws, 0, 32768, stream) != hipSuccess) { fprintf(stderr, "kernel_launch: memset of the barrier words failed\n"); return; }
    hipLaunchKernelGGL(fwd_megakernel, dim3(grid), dim3(NTHR), LDS_BYTES, stream, a);
    const hipError_t e = hipPeekAtLastError();
    if (e != hipSuccess) fprintf(stderr, "kernel_launch: launch failed: %s (grid %d)\n", hipGetErrorName(e), grid);
}
```
